# Optimizing an MI355X kernel written in HIP

```python
import jax, jax.numpy as jnp
from jax import lax
import numpy as np

D_MODEL = 4096
BATCH = 4
SEQ = 4096
DEPTH = 2

N_MIXERS = 2
N_META = 16
GLA_HEADS = 4
GLA_DK = D_MODEL // 2 // GLA_HEADS
GLA_DV = D_MODEL // GLA_HEADS
GLA_QK = GLA_HEADS * GLA_DK
GLA_V = GLA_HEADS * GLA_DV
GLA_GATE_RANK = 16
GLA_GATE_TAU = 16.0
GLA_IN = 2 * GLA_QK + 2 * GLA_V + GLA_GATE_RANK
CHUNK = 64
CONV_WIDTH = 3
D_FF = -(-8 * D_MODEL // (3 * 256)) * 256
N_GLA = (DEPTH + 1) // 2
N_CONV = DEPTH // 2
EPS = 1e-6

kernel_name = "hybrid_gla_shortconv_meta_trunk"


def rms_norm(x, g):
    xf = x.astype(jnp.float32)
    y = xf * lax.rsqrt(jnp.mean(xf * xf, axis=-1, keepdims=True) + EPS)
    return (y * g.astype(jnp.float32)).astype(x.dtype)


def gla_mixer(h, w_in, w_a2, b_a, head_norm, w_out):
    B, L, _ = h.shape
    proj = h @ w_in
    q, k, v, r, a_low = jnp.split(proj, np.cumsum([GLA_QK, GLA_QK, GLA_V, GLA_V]).tolist(), axis=-1)
    log_a = jax.nn.log_sigmoid((a_low @ w_a2 + b_a).astype(jnp.float32)) / GLA_GATE_TAU
    q = q.astype(jnp.float32) * (GLA_DK ** -0.5)
    pad = CHUNK - N_META

    def to_chunks(t, d):
        t = jnp.pad(t.astype(jnp.float32), ((0, 0), (pad, 0), (0, 0)))
        n = t.shape[1] // CHUNK
        return t.reshape(B, n, CHUNK, GLA_HEADS, d).transpose(1, 0, 3, 2, 4)

    qc = to_chunks(q, GLA_DK)
    kc = to_chunks(k, GLA_DK)
    vc = to_chunks(v, GLA_DV)
    gc = to_chunks(log_a, GLA_DK)
    causal = jnp.tril(jnp.ones((CHUNK, CHUNK), dtype=bool))[None, None, :, :, None]

    def step(S, inp):
        qi, ki, vi, gi = inp
        b = jnp.cumsum(gi, axis=2)
        b_last = b[:, :, -1:, :]
        o_inter = jnp.einsum('bhik,bhkv->bhiv', qi * jnp.exp(b), S)
        diff = jnp.where(causal, b[:, :, :, None, :] - b[:, :, None, :, :], -jnp.inf)
        scores = jnp.sum(qi[:, :, :, None, :] * ki[:, :, None, :, :] * jnp.exp(diff), axis=-1)
        o_intra = jnp.einsum('bhij,bhjv->bhiv', scores, vi)
        S_new = jnp.exp(b_last[:, :, 0, :])[..., None] * S + jnp.einsum('bhjk,bhjv->bhkv', ki * jnp.exp(b_last - b), vi)
        return S_new, o_inter + o_intra

    S0 = jnp.zeros((B, GLA_HEADS, GLA_DK, GLA_DV), jnp.float32)
    _, o = lax.scan(step, S0, (qc, kc, vc, gc))
    o = o.transpose(1, 0, 3, 2, 4).reshape(B, -1, GLA_HEADS, GLA_DV)[:, pad:]
    o = o * lax.rsqrt(jnp.mean(o * o, axis=-1, keepdims=True) + EPS) * head_norm.astype(jnp.float32)
    o = o * jax.nn.silu(r.astype(jnp.float32)).reshape(B, L, GLA_HEADS, GLA_DV)
    return o.reshape(B, L, GLA_V).astype(h.dtype) @ w_out


def conv_mixer(h, w_in, conv_w, w_out):
    L = h.shape[1]
    bg, cg, u = jnp.split(h @ w_in, 3, axis=-1)
    z = cg * u
    zp = jnp.pad(z, ((0, 0), (CONV_WIDTH - 1, 0), (0, 0)))
    conv = conv_w[CONV_WIDTH - 1] * z
    for j in range(CONV_WIDTH - 1):
        conv = conv + conv_w[j] * zp[:, j:j + L]
    return (bg * conv) @ w_out


def swiglu(h, w_gate, w_up, w_down):
    return (jax.nn.silu(h @ w_gate) * (h @ w_up)) @ w_down


def setup_inputs(seed: int = 0) -> dict:
    key = jax.random.key(seed)
    ks = jax.random.split(key, 20)
    nrm = jax.random.normal
    f = jnp.float32
    return {
        "x": nrm(ks[0], (BATCH, SEQ, D_MODEL), f),
        "meta": nrm(ks[1], (N_META, D_MODEL), f),
        "norm_mix": 1.0 + 0.01 * nrm(ks[2], (DEPTH, D_MODEL), f),
        "norm_ffn": 1.0 + 0.01 * nrm(ks[3], (DEPTH, D_MODEL), f),
        "gla_w_in": nrm(ks[4], (N_GLA, D_MODEL, GLA_IN), f) * D_MODEL ** -0.5,
        "gla_w_a2": nrm(ks[5], (N_GLA, GLA_GATE_RANK, GLA_QK), f) * GLA_GATE_RANK ** -0.5,
        "gla_b_a": 0.01 * nrm(ks[6], (N_GLA, GLA_QK), f),
        "gla_head_norm": 1.0 + 0.01 * nrm(ks[7], (N_GLA, GLA_DV), f),
        "gla_w_out": nrm(ks[8], (N_GLA, GLA_V, D_MODEL), f) * GLA_V ** -0.5,
        "conv_w_in": nrm(ks[9], (N_CONV, D_MODEL, 3 * D_MODEL), f) * D_MODEL ** -0.5,
        "conv_w": nrm(ks[10], (N_CONV, CONV_WIDTH, D_MODEL), f) * CONV_WIDTH ** -0.5,
        "conv_w_out": nrm(ks[11], (N_CONV, D_MODEL, D_MODEL), f) * D_MODEL ** -0.5,
        "ffn_w_gate": nrm(ks[12], (DEPTH, D_MODEL, D_FF), f) * D_MODEL ** -0.5,
        "ffn_w_up": nrm(ks[13], (DEPTH, D_MODEL, D_FF), f) * D_MODEL ** -0.5,
        "ffn_w_down": nrm(ks[14], (DEPTH, D_FF, D_MODEL), f) * D_FF ** -0.5,
        "norm_final": 1.0 + 0.01 * nrm(ks[15], (D_MODEL,), f),
    }


def reference(x, meta, norm_mix, norm_ffn, gla_w_in, gla_w_a2, gla_b_a, gla_head_norm, gla_w_out,
              conv_w_in, conv_w, conv_w_out, ffn_w_gate, ffn_w_up, ffn_w_down, norm_final):
    B = x.shape[0]
    h = jnp.concatenate([jnp.broadcast_to(meta.astype(x.dtype)[None], (B, N_META, D_MODEL)), x], axis=1)
    for i in range(DEPTH):
        hn = rms_norm(h, norm_mix[i])
        j = i // N_MIXERS
        if i % N_MIXERS == 0:
            h = h + gla_mixer(hn, gla_w_in[j], gla_w_a2[j], gla_b_a[j], gla_head_norm[j], gla_w_out[j])
        else:
            h = h + conv_mixer(hn, conv_w_in[j], conv_w[j], conv_w_out[j])
        h = h + swiglu(rms_norm(h, norm_ffn[i]), ffn_w_gate[i], ffn_w_up[i], ffn_w_down[i])
    return rms_norm(h, norm_final)[:, N_META:]
```

```cpp
#include <hip/hip_runtime.h>
#include <cstdio>
#include <cstdint>
namespace pg8 {
#define PG8_LAS __attribute__((address_space(3)))
typedef unsigned short bf16_t;
typedef short bf16x8 __attribute__((ext_vector_type(8)));
typedef float f32x4 __attribute__((ext_vector_type(4)));
typedef unsigned u32x4 __attribute__((ext_vector_type(4)));
constexpr int BM = 256, BK = 64, HALF = 128, HTB = HALF * BK * 2  , STAGE_BYTES = 8 * HTB, NXCD = 8, WGM = 8;

__host__ __device__ __forceinline__ int lds_byte(int r, int c) { const int st = (r >> 4) * 2 + (c >> 5), rr = r & 15, cc = c & 31, ob = rr * 64 + cc * 2; return st * 1024 + (ob ^ (((ob >> 9) & 1) << 5)); }
__host__ __device__ __forceinline__ void stage_rc(int b, int& R, int& C) { const int st = b / 1024, sb = b % 1024, swz = sb ^ (((sb >> 9) & 1) << 5); R = (st >> 1) * 16 + swz / 64; C = (st & 1) * 32 + (swz % 64) / 2; }
__host__ __device__ __forceinline__ int perm32(int rho) { const int n = rho >> 4, i = rho & 15; return 8 * (i >> 2) + 4 * n + (i & 3); }

struct Unit { int pm, pn; };
struct Gemm { const bf16_t* A; const bf16_t* Bt; int M, N, K; };

struct StaticOrder {
    int nM, nN, nwg, G, c;
    __host__ __device__ void init(int M, int N, int G_, int c_) { nM = M / BM; nN = N / BM; nwg = nM * nN; G = G_; c = c_; }
    __host__ __device__ bool next(int i, Unit& u) const {
        const long L = (long)i * G + c; if (L >= nwg) return false;
        int wgid = (int)L; { const int q = nwg / NXCD, r = nwg % NXCD, xcd = wgid % NXCD, off = wgid / NXCD; wgid = (xcd < r ? xcd * (q + 1) : r * (q + 1) + (xcd - r) * q) + off; }
        const int nig = WGM * nN, gid = wgid / nig, fm = gid * WGM, gsz = (nM - fm) < WGM ? (nM - fm) : WGM;
        u.pm = fm + ((wgid % nig) % gsz); u.pn = (wgid % nig) / gsz; return true;
    }
    __device__ __forceinline__ void a_ready(const Unit&) const {}
    __device__ __forceinline__ void done(const Unit&) const {}
    __device__ __forceinline__ void after_epi(const Unit&) const {}
};


struct StaticOrderPN : StaticOrder {
    __host__ __device__ bool next(int i, Unit& u) const {
        const long L = (long)i * G + c; if (L >= nwg) return false;
        int wgid = (int)L; { const int q = nwg / NXCD, r = nwg % NXCD, xcd = wgid % NXCD, off = wgid / NXCD; wgid = (xcd < r ? xcd * (q + 1) : r * (q + 1) + (xcd - r) * q) + off; }
        const int nig = WGM * nN, gid = wgid / nig, fm = gid * WGM, idx = wgid % nig;
        u.pm = fm + idx / nN; u.pn = idx % nN; return true;
    }
};

__device__ __forceinline__ unsigned cvt_pk_bf16(float lo, float hi) { unsigned r; asm volatile("v_cvt_pk_bf16_f32 %0, %1, %2" : "=v"(r) : "v"(lo), "v"(hi)); return r; }
__device__ __forceinline__ float rstd_of(float ss) { return 1.0f / sqrtf(ss * (1.0f / 4096.0f) + 1e-6f); }
__device__ __forceinline__ float silu_f(float x) { return x * __builtin_amdgcn_rcpf(1.0f + __expf(-x)); }

struct EpiScaleBf16 {
    static constexpr bool PERM = true, AFTER_DRAIN = false;
    bf16_t* O; int ldc; mutable int cnt;
    __device__ __forceinline__ void operator()(const f32x4 (&acc)[2][2][4][2], const Unit& u, int wr, int wc, int fr, int fq) const {
        const int row0 = u.pm * BM + wr * 64 + fr, col0 = u.pn * BM + wc * 32 + 8 * fq; const PG8_LAS float* tb = (const PG8_LAS float*)(unsigned)131072 + (cnt & 1) * 256 + wr * 64 + fr; ++cnt;
#pragma unroll
        for (int ai = 0; ai < 2; ++ai)
#pragma unroll
            for (int m = 0; m < 4; ++m) { const int row = row0 + ai * HALF + m * 16; const float sc = tb[ai * HALF + m * 16]; bf16_t* rowp = O + (size_t)row * ldc + col0;
#pragma unroll
                for (int bj = 0; bj < 2; ++bj) { const f32x4 v0 = acc[ai][bj][m][0] * sc, v1 = acc[ai][bj][m][1] * sc;
                    u32x4 w; w.x = cvt_pk_bf16(v0[0], v0[1]); w.y = cvt_pk_bf16(v0[2], v0[3]); w.z = cvt_pk_bf16(v1[0], v1[1]); w.w = cvt_pk_bf16(v1[2], v1[3]);
                    __builtin_nontemporal_store(w, (u32x4*)(rowp + bj * HALF)); } }
    }
};
struct EpiSwiGLU {
    static constexpr bool PERM = true, AFTER_DRAIN = false;
    bf16_t* O; int ldc; mutable int cnt;
    __device__ __forceinline__ void operator()(const f32x4 (&acc)[2][2][4][2], const Unit& u, int wr, int wc, int fr, int fq) const {
        const int row0 = u.pm * BM + wr * 64 + fr, col0 = u.pn * HALF + wc * 32 + 8 * fq; const PG8_LAS float* tb = (const PG8_LAS float*)(unsigned)131072 + (cnt & 1) * 256 + wr * 64 + fr; ++cnt;
#pragma unroll
        for (int ai = 0; ai < 2; ++ai)
#pragma unroll
            for (int m = 0; m < 4; ++m) { const int row = row0 + ai * HALF + m * 16; const float sc = tb[ai * HALF + m * 16];
                float a[8];
#pragma unroll
                for (int n = 0; n < 2; ++n)
#pragma unroll
                    for (int j = 0; j < 4; ++j) { const float g = acc[ai][0][m][n][j] * sc, up = acc[ai][1][m][n][j] * sc; a[4 * n + j] = silu_f(g) * up; }
                u32x4 w; w.x = cvt_pk_bf16(a[0], a[1]); w.y = cvt_pk_bf16(a[2], a[3]); w.z = cvt_pk_bf16(a[4], a[5]); w.w = cvt_pk_bf16(a[6], a[7]);
                __builtin_nontemporal_store(w, (u32x4*)(O + (size_t)row * ldc + col0)); }
    }
};
template <bool RB>
struct EpiResid {
    static constexpr bool PERM = true, AFTER_DRAIN = false;
    static constexpr int MB = RB ? 4 : 2;
    const float* resid; bf16_t* XB; float* ss_out; int ldc;
    __device__ __forceinline__ void operator()(const f32x4 (&acc)[2][2][4][2], const Unit& u, int wr, int wc, int fr, int fq) const {
        const int row0 = u.pm * BM + wr * 64 + fr, col0 = u.pn * BM + wc * 32 + 8 * fq;
#pragma unroll
        for (int ai = 0; ai < 2; ++ai)
#pragma unroll
          for (int mb = 0; mb < 4; mb += MB) {
            u32x4 rb[MB][2]; f32x4 rf[RB ? 1 : MB][2][2];
#pragma unroll
            for (int mm = 0; mm < MB; ++mm) { const size_t off = (size_t)(row0 + ai * HALF + (mb + mm) * 16) * ldc + col0;
#pragma unroll
                for (int bj = 0; bj < 2; ++bj) {
                    if constexpr (RB) rb[mm][bj] = *(const u32x4*)(XB + off + bj * HALF);
                    else { rf[mm][bj][0] = *(const f32x4*)(resid + off + bj * HALF); rf[mm][bj][1] = *(const f32x4*)(resid + off + bj * HALF + 4); } } }
#pragma unroll
            for (int mm = 0; mm < MB; ++mm) { const int m = mb + mm, row = row0 + ai * HALF + m * 16; const size_t off = (size_t)row * ldc + col0; float s = 0.f;
#pragma unroll
                for (int bj = 0; bj < 2; ++bj) { f32x4 r0, r1;
                    if constexpr (RB) { const u32x4 q = rb[mm][bj];
                        r0[0] = __builtin_bit_cast(float, q.x << 16); r0[1] = __builtin_bit_cast(float, q.x & 0xffff0000u); r0[2] = __builtin_bit_cast(float, q.y << 16); r0[3] = __builtin_bit_cast(float, q.y & 0xffff0000u);
                        r1[0] = __builtin_bit_cast(float, q.z << 16); r1[1] = __builtin_bit_cast(float, q.z & 0xffff0000u); r1[2] = __builtin_bit_cast(float, q.w << 16); r1[3] = __builtin_bit_cast(float, q.w & 0xffff0000u); }
                    else { r0 = rf[mm][bj][0]; r1 = rf[mm][bj][1]; }
                    const f32x4 v0 = acc[ai][bj][m][0] + r0, v1 = acc[ai][bj][m][1] + r1;
                    u32x4 w; w.x = cvt_pk_bf16(v0[0], v0[1]); w.y = cvt_pk_bf16(v0[2], v0[3]); w.z = cvt_pk_bf16(v1[0], v1[1]); w.w = cvt_pk_bf16(v1[2], v1[3]);
                    *(u32x4*)(XB + off + bj * HALF) = w;
                    s += (v0[0] * v0[0] + v0[1] * v0[1]) + (v0[2] * v0[2] + v0[3] * v0[3]) + (v1[0] * v1[0] + v1[1] * v1[1]) + (v1[2] * v1[2] + v1[3] * v1[3]); }
                s += __shfl_xor(s, 16); s += __shfl_xor(s, 32);
                if (fq == 0) ss_out[((size_t)(u.pm * (ldc / BM) + u.pn) * BM + (row - u.pm * BM)) * 4 + wc] = s; }
            asm volatile("" ::: "memory"); }
    }
};

struct RstdOrder : StaticOrder {
    const float* ssp; const float* ss0; int npn; mutable int cnt; mutable int pmA, pmB;
    static __device__ __forceinline__ PG8_LAS float* tbl() { return (PG8_LAS float*)(unsigned)131072; }
    __device__ __forceinline__ void build(const Unit& u) const {
        const int par = cnt & 1; const bool same = cnt >= 2 && (par ? pmB : pmA) == u.pm; if (par) pmB = u.pm; else pmA = u.pm; ++cnt; const int tid = threadIdx.x;
        if (same) return;
        if (tid < 256) { float s;
            if (ssp) { const char* base = (const char*)(ssp + (size_t)(u.pm * npn) * 1024); int to = tid * 16; asm volatile("" : "+v"(to));
                s = 0.f;
#pragma unroll
                for (int pn = 0; pn < 16; ++pn) { const f32x4 v = *(const f32x4*)(base + (size_t)pn * 4096 + (size_t)(unsigned)to); s += (v[0] + v[1]) + (v[2] + v[3]); } }
            else s = ss0[u.pm * BM + tid];
            tbl()[par * 256 + tid] = rstd_of(s); }
    }
    __device__ __forceinline__ void a_ready(const Unit& u) const { if (cnt == 0) build(u); }
    __device__ __forceinline__ void after_epi(const Unit& u) const { build(u); }
};

template <class Epi, class Sched, bool ALIGN_EPI = false, bool SP2 = false>
__device__ __forceinline__ void gemm_phase(PG8_LAS unsigned char* lds, const Gemm g, const Sched& S, const Epi& E) {
    const int tid = threadIdx.x, wid = __builtin_amdgcn_readfirstlane(tid >> 6), lane = tid & 63, wr = wid >> 2, wc = wid & 3, fr = lane & 15, fq = lane >> 4;
    const int K = g.K, nt = K / BK;
    unsigned voffA[2], voffB[2];
#pragma unroll
    for (int i = 0; i < 2; ++i) { int R, C; stage_rc(tid * 16 + i * 8192, R, C); const int Rb = Epi::PERM ? ((R & ~31) + perm32(R & 31)) : R;
        voffA[i] = (unsigned)(R * K + C) * 2u; voffB[i] = (unsigned)(Rb * K + C) * 2u; }
    const size_t kstep = (size_t)(BK * 2);
    const size_t hstep = (size_t)HALF * K * 2;
    const size_t tstep = 2 * hstep;
    const unsigned ldsw = (unsigned)wid * 1024u;
    const int aoff = lds_byte(wr * 64 + fr, fq * 8), boff = lds_byte(wc * 32 + fr, fq * 8);
#define PG8_SA(b, h) (((b) * 2 + (h)) * HTB)
#define PG8_SB(b, h) ((4 + (b) * 2 + (h)) * HTB)
#define PG8_STAGE(bufoff, gbase, voff) do { _Pragma("unroll") for (int _i = 0; _i < 2; ++_i) \
        __builtin_amdgcn_global_load_lds((const unsigned*)((const char*)(gbase) + (voff)[_i]), (PG8_LAS unsigned*)(lds + (bufoff) + ldsw + _i * 8192), 16, 0, 0); } while (0)
#define PG8_LDA(dst, b, h) do { _Pragma("unroll") for (int m = 0; m < 4; ++m) _Pragma("unroll") for (int k = 0; k < 2; ++k) dst[m][k] = *(const PG8_LAS bf16x8*)(lds + PG8_SA(b, h) + aoff + m * 2048 + k * 1024); } while (0)
#define PG8_LDB(dst, b, h) do { _Pragma("unroll") for (int n = 0; n < 2; ++n) _Pragma("unroll") for (int k = 0; k < 2; ++k) dst[n][k] = *(const PG8_LAS bf16x8*)(lds + PG8_SB(b, h) + boff + n * 2048 + k * 1024); } while (0)
#define PG8_MMA(ai, bj, At, Bt) do { __builtin_amdgcn_s_setprio(1); _Pragma("unroll") for (int m = 0; m < 4; ++m) _Pragma("unroll") for (int n = 0; n < 2; ++n) _Pragma("unroll") for (int k = 0; k < 2; ++k) \
        acc[ai][bj][m][n] = __builtin_amdgcn_mfma_f32_16x16x32_bf16(Bt[n][k], At[m][k], acc[ai][bj][m][n], 0, 0, 0); __builtin_amdgcn_s_setprio(0); } while (0)
#define PG8_WAIT_V(n) asm volatile("s_waitcnt vmcnt(" #n ")" ::: "memory")
#define PG8_WAIT_L(n) asm volatile("s_waitcnt lgkmcnt(" #n ")" ::: "memory")
#define PG8_BAR __builtin_amdgcn_s_barrier()
#define PG8_SCHED __builtin_amdgcn_sched_barrier(0)
    Unit cur, nxt; int ui = 0;
    if (!S.next(0, cur)) return;
    f32x4 acc[2][2][4][2];
#pragma unroll
    for (int a = 0; a < 2; ++a)
#pragma unroll
        for (int b = 0; b < 2; ++b)
#pragma unroll
            for (int m = 0; m < 4; ++m)
#pragma unroll
                for (int n = 0; n < 2; ++n) acc[a][b][m][n] = (f32x4){0.f, 0.f, 0.f, 0.f};
    bf16x8 At[4][2], B0[2][2], B1[2][2];
    const char* cA = (const char*)g.A + (size_t)cur.pm * tstep; const char* cB = (const char*)g.Bt + (size_t)cur.pn * tstep;
    S.a_ready(cur);
    if constexpr (SP2) {
        PG8_STAGE(PG8_SB(0, 0), cB, voffB); PG8_STAGE(PG8_SB(0, 1), cB + hstep, voffB); PG8_STAGE(PG8_SA(0, 0), cA, voffA); PG8_STAGE(PG8_SA(0, 1), cA + hstep, voffA);
        if (wr == 1) PG8_BAR;
        PG8_WAIT_V(2); PG8_BAR;
        PG8_STAGE(PG8_SB(1, 0), cB + kstep, voffB); PG8_STAGE(PG8_SA(1, 0), cA + kstep, voffA); PG8_STAGE(PG8_SB(1, 1), cB + hstep + kstep, voffB);
        PG8_WAIT_V(6); PG8_BAR;
    } else {
        PG8_STAGE(PG8_SB(0, 0), cB, voffB); PG8_STAGE(PG8_SA(0, 0), cA, voffA); PG8_STAGE(PG8_SB(0, 1), cB + hstep, voffB); PG8_STAGE(PG8_SA(0, 1), cA + hstep, voffA);
        if (wr == 1) PG8_BAR;
        PG8_WAIT_V(4); PG8_BAR;
        PG8_STAGE(PG8_SB(1, 0), cB + kstep, voffB); PG8_STAGE(PG8_SA(1, 0), cA + kstep, voffA); PG8_STAGE(PG8_SB(1, 1), cB + hstep + kstep, voffB);
        PG8_WAIT_V(6); PG8_BAR;
    }
    for (;;) {
        const bool has_next = S.next(ui + 1, nxt);
        const char* nA = has_next ? (const char*)g.A + (size_t)nxt.pm * tstep : cA; const char* nB = has_next ? (const char*)g.Bt + (size_t)nxt.pn * tstep : cB;
        for (int t = 0; t < nt; t += 2) {
            const bool last = (t == nt - 2);
            const char* a1 = cA + (size_t)(t + 1) * kstep;
            const char* a2 = last ? nA : cA + (size_t)(t + 2) * kstep; const char* b2 = last ? nB : cB + (size_t)(t + 2) * kstep;
            const char* a3 = a2 + kstep; const char* b3 = b2 + kstep;
            if (last && has_next) S.a_ready(nxt);
            if constexpr (SP2) {
            PG8_LDB(B0, 0, 0); PG8_LDB(B1, 0, 1); PG8_SCHED; PG8_LDA(At, 0, 0); PG8_STAGE(PG8_SA(1, 1), a1 + hstep, voffA);
            PG8_WAIT_V(8); PG8_WAIT_L(0); PG8_BAR; PG8_MMA(0, 0, At, B0); PG8_MMA(0, 1, At, B1); PG8_BAR; PG8_SCHED;
            PG8_LDA(At, 0, 1); PG8_STAGE(PG8_SB(0, 0), b2, voffB); PG8_STAGE(PG8_SB(0, 1), b2 + hstep, voffB); PG8_STAGE(PG8_SA(0, 0), a2, voffA);
            PG8_WAIT_V(8); PG8_WAIT_L(0); PG8_BAR; PG8_MMA(1, 0, At, B0); PG8_MMA(1, 1, At, B1); PG8_BAR; PG8_SCHED;
            PG8_LDB(B0, 1, 0); PG8_LDB(B1, 1, 1); PG8_SCHED; PG8_LDA(At, 1, 0); PG8_STAGE(PG8_SA(0, 1), a2 + hstep, voffA);
            PG8_WAIT_V(8); PG8_WAIT_L(0); PG8_BAR; PG8_MMA(0, 0, At, B0); PG8_MMA(0, 1, At, B1); PG8_BAR; PG8_SCHED;
            PG8_LDA(At, 1, 1); PG8_STAGE(PG8_SB(1, 0), b3, voffB); PG8_STAGE(PG8_SB(1, 1), b3 + hstep, voffB); PG8_STAGE(PG8_SA(1, 0), a3, voffA);
            PG8_WAIT_V(8); PG8_WAIT_L(0); PG8_BAR; PG8_MMA(1, 0, At, B0); PG8_MMA(1, 1, At, B1); PG8_BAR; PG8_SCHED;
            } else {
            PG8_LDB(B0, 0, 0); PG8_SCHED; PG8_LDA(At, 0, 0); PG8_STAGE(PG8_SA(1, 1), a1 + hstep, voffA);
            PG8_WAIT_L(8); PG8_BAR; PG8_WAIT_L(0); PG8_MMA(0, 0, At, B0); PG8_BAR; PG8_SCHED;
            PG8_LDB(B1, 0, 1); PG8_STAGE(PG8_SB(0, 0), b2, voffB);
            PG8_BAR; PG8_WAIT_L(0); PG8_MMA(0, 1, At, B1); PG8_BAR;
            PG8_LDA(At, 0, 1); PG8_STAGE(PG8_SA(0, 0), a2, voffA);
            PG8_BAR; PG8_WAIT_L(0); PG8_MMA(1, 0, At, B0); PG8_BAR; PG8_SCHED;
            PG8_STAGE(PG8_SB(0, 1), b2 + hstep, voffB);
            PG8_WAIT_V(6); PG8_BAR; PG8_MMA(1, 1, At, B1); PG8_BAR;
            PG8_LDB(B0, 1, 0); PG8_SCHED; PG8_LDA(At, 1, 0); PG8_STAGE(PG8_SA(0, 1), a2 + hstep, voffA);
            PG8_WAIT_L(8); PG8_BAR; PG8_WAIT_L(0); PG8_MMA(0, 0, At, B0); PG8_BAR; PG8_SCHED;
            PG8_LDB(B1, 1, 1); PG8_STAGE(PG8_SB(1, 0), b3, voffB);
            PG8_BAR; PG8_WAIT_L(0); PG8_MMA(0, 1, At, B1); PG8_BAR;
            PG8_LDA(At, 1, 1); PG8_STAGE(PG8_SA(1, 0), a3, voffA);
            PG8_BAR; PG8_WAIT_L(0); PG8_MMA(1, 0, At, B0); PG8_BAR; PG8_SCHED;
            PG8_STAGE(PG8_SB(1, 1), b3 + hstep, voffB);
            PG8_WAIT_V(6); PG8_BAR; PG8_MMA(1, 1, At, B1); PG8_BAR;
            }
        }
        if constexpr (ALIGN_EPI) { if (wr == 0) PG8_BAR; }
        if constexpr (!Epi::AFTER_DRAIN) { E(acc, cur, wr, wc, fr, fq); S.done(cur); __builtin_amdgcn_sched_barrier(0); if (has_next) S.after_epi(nxt); __builtin_amdgcn_sched_barrier(0); }
        if (!has_next) break;
#pragma unroll
        for (int a = 0; a < 2; ++a)
#pragma unroll
            for (int b = 0; b < 2; ++b)
#pragma unroll
                for (int m = 0; m < 4; ++m)
#pragma unroll
                    for (int n = 0; n < 2; ++n) acc[a][b][m][n] = (f32x4){0.f, 0.f, 0.f, 0.f};
        cur = nxt; cA = nA; cB = nB; ++ui;
        if constexpr (ALIGN_EPI) { if (wr == 1) PG8_BAR; }
    }
    PG8_WAIT_V(0);
    if constexpr (!ALIGN_EPI) { if (wr == 0) PG8_BAR; }
    PG8_BAR;
    if constexpr (Epi::AFTER_DRAIN) { E.fused(acc, cur, wr, wc, fr, fq, lds, wid, lane); S.done(cur); }
#undef PG8_SA
#undef PG8_SB
#undef PG8_STAGE
#undef PG8_LDA
#undef PG8_LDB
#undef PG8_MMA
#undef PG8_WAIT_V
#undef PG8_WAIT_L
#undef PG8_BAR
#undef PG8_SCHED
}
}

constexpr int NWAVES = 8;
constexpr int D = 4096, NB = 4, SEQ = 4096, M = NB * SEQ, NMETA = 16, LTOK = SEQ + NMETA;
constexpr int GH = 4, DK = 512, DV = 1024, QK = 2048, GV = 4096, GR = 16, GIN = 12304, NQKVR = 12288, MGIN = 12320  ;
constexpr int FF = 11008, NGU = 2 * FF;
constexpr float EPS = 1e-6f;
#define DIAG_POISON 0
#define GS_NO_DMA 0
#define GS_C_PACK 0
#ifndef MK_CUTS
#define MK_CUTS 0u
#endif
constexpr int N_PHASES = 14;

constexpr size_t MiB = 1u << 20;
constexpr size_t WS_CTL = 0, CTL_ZERO_BYTES = 2 * MiB;
constexpr size_t WS_WGIN = 2 * MiB;
constexpr size_t WS_WGOUT = 99 * MiB;
constexpr size_t WS_WGU0 = 131 * MiB;
constexpr size_t WS_WDN0 = 303 * MiB;
constexpr size_t WS_WCIN = 389 * MiB;
constexpr size_t WS_WCOUT = 485 * MiB;
constexpr size_t WS_WGU1 = 517 * MiB;
constexpr size_t WS_WDN1 = 689 * MiB;
constexpr size_t WS_XB = 775 * MiB;
constexpr size_t WS_OG = 903 * MiB;
constexpr size_t WS_PROJ = 1031 * MiB;
constexpr size_t WS_O = 1415 * MiB;
constexpr size_t WS_QDF = 1543 * MiB;
constexpr size_t WS_KDNTF = 1607 * MiB;
constexpr size_t WS_ALOW = 1671 * MiB;
constexpr size_t WS_META = 1672 * MiB;
constexpr size_t WS_SC = 1676 * MiB;
constexpr size_t WS_EBL = 1684 * MiB;
constexpr size_t WS_SSP = 1686 * MiB;
constexpr size_t WS_END = 1690 * MiB;
constexpr size_t MT_XB = 0, MT_PROJ = 128 * 1024, MT_O = MT_PROJ + 800 * 1024, MT_OG = MT_O + 256 * 1024, MT_H = MT_OG + 128 * 1024, MT_ACT = MT_H + 256 * 1024, MT_Z = MT_ACT + 352 * 1024,
                 MT_QDF = 2048 * 1024, MT_KDNTF = MT_QDF + 256 * 1024, MT_SC = MT_KDNTF + 256 * 1024, MT_EBL = MT_SC + 32 * 1024;
static_assert(MT_PROJ + (size_t)16 * MGIN * 4 <= MT_O && MT_Z + 2 * 4096 * 4 <= MT_QDF && MT_EBL + 8 * 1024 <= 4 * MiB, "meta map");
constexpr int CW_BAR = 4096;
constexpr int CW_SS = 262144;
constexpr int CW_MSS = CW_SS + 5 * M;
constexpr int MSS_STRIDE = 64;
static_assert((size_t)(CW_MSS + 5 * MSS_STRIDE) * 4 <= CTL_ZERO_BYTES && CW_BAR + N_PHASES * 3456 <= CW_SS, "ctl map");

constexpr int RING_OFF = 0, RING_BYTES = 131072;
constexpr int LDS_BYTES = 163840, LDSCTL_OFF = LDS_BYTES - 1024, MISC_OFF = LDSCTL_OFF + 320;

#define GAS __attribute__((address_space(1)))
#define LAS __attribute__((address_space(3)))
typedef unsigned short bf16;
typedef unsigned v4u __attribute__((ext_vector_type(4)));
typedef unsigned v2u __attribute__((ext_vector_type(2)));
typedef float f32x4 __attribute__((ext_vector_type(4)));
typedef short bf16x8 __attribute__((ext_vector_type(8)));
#define LDS_WAIT() asm volatile("s_waitcnt lgkmcnt(0)" ::: "memory")
#define VM_WAIT() asm volatile("s_waitcnt vmcnt(0)" ::: "memory")
__device__ __forceinline__ unsigned f2bf(float f) { unsigned u = __builtin_bit_cast(unsigned, f); return (u + 0x7fffu + ((u >> 16) & 1u)) >> 16; }
__device__ __forceinline__ unsigned pk2(float lo, float hi) { return f2bf(lo) | (f2bf(hi) << 16); }
__device__ __forceinline__ float bf2f(unsigned short b) { return __builtin_bit_cast(float, (unsigned)b << 16); }
__device__ __forceinline__ float bflo(unsigned w) { return __builtin_bit_cast(float, w << 16); }
__device__ __forceinline__ float bfhi(unsigned w) { return __builtin_bit_cast(float, w & 0xffff0000u); }
__device__ __forceinline__ float wave_sum(float v) {
#pragma unroll
    for (int o = 1; o < 64; o <<= 1) v += __shfl_xor(v, o);
    return v;
}
using pg8::rstd_of; using pg8::silu_f;

#define XB_TMO      128
#define XB_XCNT(j)  (256  + 64 * (j))
#define XB_XSUB(j)  (1280 + 64 * (j))
#define XB_XGEN(j)  (2304 + 64 * (j))
#define XB_TOP      3328
#define XB_TOPGEN   3392
#define XCD_BAR_WORDS 3456
#define XB_SPIN_CAP (1u << 18)

__device__ __forceinline__ unsigned xb_ld(unsigned* p)              { return __hip_atomic_load(p, __ATOMIC_RELAXED, __HIP_MEMORY_SCOPE_AGENT); }
__device__ __forceinline__ unsigned xb_add(unsigned* p, unsigned v) { return __hip_atomic_fetch_add(p, v, __ATOMIC_RELAXED, __HIP_MEMORY_SCOPE_AGENT); }
__device__ __forceinline__ unsigned xb_xcc_id() { return (unsigned)__builtin_amdgcn_s_getreg((3 << 11) | 20) & 0xFu; }
#define XB_SPIN(cond, bar) do { unsigned _sp = 0; while (cond) { __builtin_amdgcn_s_sleep(1); \
    if ((++_sp & 255u) == 0u) { if (xb_ld(&(bar)[XB_TMO])) break; if (_sp > XB_SPIN_CAP) { atomicAdd(&(bar)[XB_TMO], 1u); break; } } } } while (0)

struct XcdBarrier {
    unsigned* bar; unsigned x;
    volatile LAS unsigned* st;
};

__device__ __forceinline__ XcdBarrier xcd_barrier_post(unsigned* bar, volatile LAS unsigned* st) {
    XcdBarrier b; b.bar = bar; b.x = xb_xcc_id(); b.st = st;
    if (threadIdx.x == 0) (void)xb_add(&bar[XB_XCNT(b.x)], 1u);
    return b;
}
__device__ __forceinline__ void xcd_barrier_complete(unsigned* bar, unsigned x, unsigned& nloc, unsigned& nx) {
    const unsigned G = gridDim.x * gridDim.y * gridDim.z;
    unsigned sum, cnt, mine, sp = 0u;
    for (;;) {
        sum = 0u; cnt = 0u; mine = 0u;
#pragma unroll
        for (unsigned j = 0; j < 16; ++j) { const unsigned c = xb_ld(&bar[XB_XCNT(j)]); sum += c; cnt += (c > 0u) ? 1u : 0u; mine = (j == x) ? c : mine; }
        if (sum == G) break;
        __builtin_amdgcn_s_sleep(1);
        if ((++sp & 255u) == 0u) { if (xb_ld(&bar[XB_TMO])) break; if (sp > XB_SPIN_CAP) { atomicAdd(&bar[XB_TMO], 1u); break; } }
    }
    nloc = mine > 0u ? mine : 1u; nx = cnt > 0u ? cnt : 1u;
}

__device__ __forceinline__ void xcd_barrier(const XcdBarrier& b) {
    asm volatile("s_waitcnt vmcnt(0)" ::: "memory");
    __syncthreads();
    if (threadIdx.x == 0) {
        unsigned* bar = b.bar;
        __builtin_amdgcn_s_waitcnt(0);
        unsigned nloc = b.st[0], nx = b.st[1];
        if (nloc == 0u) { xcd_barrier_complete(bar, b.x, nloc, nx); b.st[0] = nloc; b.st[1] = nx; }
        const unsigned old = xb_add(&bar[XB_XSUB(b.x)], 1u);
        const unsigned gen = old / nloc;
        if (old + 1u == (gen + 1u) * nloc) {
            __builtin_amdgcn_fence(__ATOMIC_RELEASE, "agent");
            asm volatile("s_waitcnt vmcnt(0)" ::: "memory");
            const unsigned og = xb_add(&bar[XB_TOP], 1u);
            const unsigned tg = og / nx;
            if (og + 1u == (tg + 1u) * nx) xb_add(&bar[XB_TOPGEN], 1u);
            else XB_SPIN(xb_ld(&bar[XB_TOPGEN]) == tg, bar);
            __builtin_amdgcn_fence(__ATOMIC_ACQUIRE, "agent");
            xb_add(&bar[XB_XGEN(b.x)], 1u);
            asm volatile("s_waitcnt vmcnt(0)" ::: "memory");
        } else {
            XB_SPIN(xb_ld(&bar[XB_XGEN(b.x)]) == gen, bar);
            __builtin_amdgcn_fence(__ATOMIC_ACQUIRE, "agent");
            asm volatile("s_waitcnt vmcnt(0)" ::: "memory");
        }
    }
    __syncthreads();
}

template <int MODE>
__device__ __forceinline__ void cvt_task(const float* __restrict__ W, int K, int ldw, int ncols, const float* __restrict__ gk, bf16* __restrict__ WT, LAS float* scr, int gw, int ngw, int lane) {
    const int nblk = (ncols + 31) / 32, nitems = (K / 64) * nblk, n = lane & 31, hi = lane >> 5, c = lane & 7;
    float v[32];
#define CVT_LOAD(it_) do { const int kb_ = (it_) / nblk, n0_ = ((it_) % nblk) * 32; const bool ok_ = n0_ + n < ncols; const float* wp_ = W + (size_t)(kb_ * 64 + hi) * ldw + n0_ + n; \
        _Pragma("unroll") for (int i = 0; i < 32; ++i) v[i] = ok_ ? wp_[(size_t)(2 * i) * ldw] : 0.f; } while (0)
    int it = gw;
    if (it < nitems) CVT_LOAD(it);
    while (it < nitems) {
        const int kb = it / nblk, n0 = (it % nblk) * 32, k0 = kb * 64; const int ncv = (ncols - n0) < 32 ? (ncols - n0) : 32;
        long dr = n0; if (MODE == 1) dr = (long)(n0 / 128) * 256 + (n0 % 128); if (MODE == 2) dr = (long)(n0 / 128) * 256 + 128 + (n0 % 128);
#pragma unroll
        for (int i = 0; i < 32; ++i) scr[(2 * i + hi) * 33 + n] = v[i];
        f32x4 ga = {1.f, 1.f, 1.f, 1.f}, gb = {1.f, 1.f, 1.f, 1.f};
        if (gk) { ga = *(const f32x4*)(gk + k0 + 8 * c); gb = *(const f32x4*)(gk + k0 + 8 * c + 4); }
        const int nxt = it + ngw;
        if (nxt < nitems) CVT_LOAD(nxt);
        LDS_WAIT(); asm volatile("" ::: "memory");
#pragma unroll
        for (int j = 0; j < 4; ++j) { const int nn = (lane >> 3) + 8 * j; const LAS float* s = scr + (8 * c) * 33 + nn;
            v4u o; o.x = pk2(s[0 * 33] * ga.x, s[1 * 33] * ga.y); o.y = pk2(s[2 * 33] * ga.z, s[3 * 33] * ga.w); o.z = pk2(s[4 * 33] * gb.x, s[5 * 33] * gb.y); o.w = pk2(s[6 * 33] * gb.z, s[7 * 33] * gb.w);
            if (nn < ncv) *(v4u*)(WT + (size_t)(dr + nn) * K + k0 + 8 * c) = o; }
        LDS_WAIT(); asm volatile("" ::: "memory");
        it = nxt;
    }
#undef CVT_LOAD
}
__device__ __forceinline__ void row_to_bf16_ss(const float* xrow, bf16* orow, float* ss, int lane) {
    const f32x4* xr = (const f32x4*)xrow + lane; f32x4 v[16]; float s = 0.f;
#pragma unroll
    for (int j = 0; j < 16; ++j) { v[j] = xr[64 * j]; s += (v[j].x * v[j].x + v[j].y * v[j].y) + (v[j].z * v[j].z + v[j].w * v[j].w); }
    s = wave_sum(s); if (lane == 0) *ss = s;
    v2u* o8 = (v2u*)orow + lane;
#pragma unroll
    for (int j = 0; j < 16; ++j) { v2u w; w.x = pk2(v[j].x, v[j].y); w.y = pk2(v[j].z, v[j].w); o8[64 * j] = w; }
}

template <bool PAIR, class Epi>
__device__ __forceinline__ void thin_gemm16(LAS unsigned char* lds, const bf16* __restrict__ A16, const bf16* __restrict__ Bt, int K, int ntiles, long pair_off, const Epi& epi, int wg, int nwg) {
    const int tid = threadIdx.x, wave = __builtin_amdgcn_readfirstlane(tid >> 6), lane = tid & 63, i = lane & 15, q = lane >> 4;
    LAS float* red = (LAS float*)lds;
    const int nblk = K / 128, kb0 = wave * nblk / 8, kb1 = (wave + 1) * nblk / 8;
    for (int t4 = wg * 4; t4 < ntiles; t4 += nwg * 4)
    for (int t = t4; t < t4 + 4 && t < ntiles; ++t) {
        const long n0 = epi.row0(t);
        const bf16* ap = A16 + (size_t)i * K + 32 * q;
        const bf16* bp = Bt + (size_t)(n0 + i) * K + 32 * q;
        const bf16* bp2 = bp + (size_t)pair_off * K;
        f32x4 acc0 = {0.f, 0.f, 0.f, 0.f}, acc1 = {0.f, 0.f, 0.f, 0.f};
#pragma unroll 2
        for (int kb = kb0; kb < kb1; ++kb) {
            const bf16x8* a = (const bf16x8*)(ap + kb * 128); const bf16x8* b = (const bf16x8*)(bp + kb * 128);
            const bf16x8 a0 = a[0], a1 = a[1], a2 = a[2], a3 = a[3], b0 = b[0], b1 = b[1], b2 = b[2], b3 = b[3];
            acc0 = __builtin_amdgcn_mfma_f32_16x16x32_bf16(a0, b0, acc0, 0, 0, 0); acc0 = __builtin_amdgcn_mfma_f32_16x16x32_bf16(a1, b1, acc0, 0, 0, 0);
            acc0 = __builtin_amdgcn_mfma_f32_16x16x32_bf16(a2, b2, acc0, 0, 0, 0); acc0 = __builtin_amdgcn_mfma_f32_16x16x32_bf16(a3, b3, acc0, 0, 0, 0);
            if (PAIR) { const bf16x8* c = (const bf16x8*)(bp2 + kb * 128); const bf16x8 c0 = c[0], c1 = c[1], c2 = c[2], c3 = c[3];
                acc1 = __builtin_amdgcn_mfma_f32_16x16x32_bf16(a0, c0, acc1, 0, 0, 0); acc1 = __builtin_amdgcn_mfma_f32_16x16x32_bf16(a1, c1, acc1, 0, 0, 0);
                acc1 = __builtin_amdgcn_mfma_f32_16x16x32_bf16(a2, c2, acc1, 0, 0, 0); acc1 = __builtin_amdgcn_mfma_f32_16x16x32_bf16(a3, c3, acc1, 0, 0, 0); }
        }
#pragma unroll
        for (int j = 0; j < 4; ++j) { red[((wave * 2 + 0) * 4 + j) * 64 + lane] = acc0[j]; if (PAIR) red[((wave * 2 + 1) * 4 + j) * 64 + lane] = acc1[j]; }
        __syncthreads();
        if (tid < 256) { const int l = tid & 63, j = tid >> 6; float v0 = 0.f, v1 = 0.f;
#pragma unroll
            for (int w = 0; w < 8; ++w) { v0 += red[((w * 2 + 0) * 4 + j) * 64 + l]; if (PAIR) v1 += red[((w * 2 + 1) * 4 + j) * 64 + l]; }
            epi(t, 4 * (l >> 4) + j, l & 15, v0, v1); }
        __syncthreads();
    }
}


__device__ __forceinline__ void thin_row_rstd(LAS float* tbl, const float* __restrict__ X) {
    const int tid = threadIdx.x, r = tid >> 5, l = tid & 31; const f32x4* xr = (const f32x4*)(X + (size_t)r * D) + l; float s = 0.f;
#pragma unroll 8
    for (int j = 0; j < 32; ++j) { const f32x4 v = xr[32 * j]; s += (v.x * v.x + v.y * v.y) + (v.z * v.z + v.w * v.w); }
    s += __shfl_xor(s, 1); s += __shfl_xor(s, 2); s += __shfl_xor(s, 4); s += __shfl_xor(s, 8); s += __shfl_xor(s, 16);
    if (l == 0) tbl[r] = rstd_of(s);
    __syncthreads();
}

struct TE_ALow {
    float* alow; const float* ss;
    __device__ __forceinline__ long row0(int t) const { return (long)t * 16; }
    __device__ __forceinline__ void operator()(int t, int r, int c, float v0, float) const { const int tok = t * 16 + c; alow[(size_t)tok * 16 + r] = v0 * rstd_of(ss[tok]); }
};
struct TE_MProj {
    float* mproj; const LAS float* rs;
    __device__ __forceinline__ long row0(int t) const { return (long)t * 16; }
    __device__ __forceinline__ void operator()(int t, int r, int c, float v0, float) const { mproj[(size_t)r * MGIN + t * 16 + c] = v0 * rs[r]; }
};
struct TE_MResid {
    const float* resid; float* mh; bf16* mxb; float* mss_out;
    __device__ __forceinline__ long row0(int t) const { return (long)t * 16; }
    __device__ __forceinline__ void operator()(int t, int r, int c, float v0, float) const {
        const size_t o = (size_t)r * D + t * 16 + c; const float h = resid[o] + v0; mh[o] = h; mxb[o] = (bf16)f2bf(h);
        (void)mss_out;
    }
};
struct TE_MSwiGLU {
    bf16* mact; const LAS float* rs;
    __device__ __forceinline__ long row0(int t) const { return (long)(t >> 3) * 256 + (t & 7) * 16; }
    __device__ __forceinline__ void operator()(int t, int r, int c, float v0, float v1) const { const float sc = rs[r];
        mact[(size_t)r * FF + (t >> 3) * 128 + (t & 7) * 16 + c] = (bf16)f2bf(silu_f(v0 * sc) * (v1 * sc)); }
};
struct TE_MConvZ {
    float* zm; const LAS float* rs;
    __device__ __forceinline__ long row0(int t) const { return 4096 + (long)t * 16; }
    __device__ __forceinline__ void operator()(int t, int r, int c, float v0, float v1) const { const float sc = rs[r];
        if (r >= 14) zm[(size_t)(r - 14) * D + t * 16 + c] = (v0 * sc) * (v1 * sc); }
};

typedef float f32x16 __attribute__((ext_vector_type(16)));
#define MFMA32(a, b, c) __builtin_amdgcn_mfma_f32_32x32x16_bf16((a), (b), (c), 0, 0, 0)
constexpr int GP_LD = 1040;
constexpr int GP_QD = 0, GP_KDN = 64 * GP_LD, GP_AL = 2 * 64 * GP_LD;
constexpr int GS_KT = 0, GS_OP = 65536, GS_VT = 131072, GS_VT_LD = 144, GS_EB = GS_VT + 64 * GS_VT_LD;
constexpr int GLA_ITEM_FR = 64 * 512;
__device__ __forceinline__ bf16x8 pack_step(const f32x16& x, int s) {
    v4u p;
#if GS_C_PACK
    if (s == 0) { p[0] = pk2(x[0], x[1]); p[1] = pk2(x[2], x[3]); p[2] = pk2(x[4], x[5]); p[3] = pk2(x[6], x[7]); }
    else { p[0] = pk2(x[8], x[9]); p[1] = pk2(x[10], x[11]); p[2] = pk2(x[12], x[13]); p[3] = pk2(x[14], x[15]); }
    return __builtin_bit_cast(bf16x8, p);
#endif
    if (s == 0) asm volatile("v_cvt_pk_bf16_f32 %0, %4, %5\n\tv_cvt_pk_bf16_f32 %1, %6, %7\n\tv_cvt_pk_bf16_f32 %2, %8, %9\n\tv_cvt_pk_bf16_f32 %3, %10, %11\n\ts_nop 1"
               : "=&v"(p[0]), "=&v"(p[1]), "=&v"(p[2]), "=&v"(p[3]) : "v"(x[0]), "v"(x[1]), "v"(x[2]), "v"(x[3]), "v"(x[4]), "v"(x[5]), "v"(x[6]), "v"(x[7]));
    else asm volatile("v_cvt_pk_bf16_f32 %0, %4, %5\n\tv_cvt_pk_bf16_f32 %1, %6, %7\n\tv_cvt_pk_bf16_f32 %2, %8, %9\n\tv_cvt_pk_bf16_f32 %3, %10, %11\n\ts_nop 1"
               : "=&v"(p[0]), "=&v"(p[1]), "=&v"(p[2]), "=&v"(p[3]) : "v"(x[8]), "v"(x[9]), "v"(x[10]), "v"(x[11]), "v"(x[12]), "v"(x[13]), "v"(x[14]), "v"(x[15]));
    return __builtin_bit_cast(bf16x8, p);
}
__device__ __forceinline__ void gla_prep_item(LAS unsigned char* sm, bool meta, const bf16* __restrict__ prow  , const float* __restrict__ arow  ,
                                              const float* __restrict__ MPROJ, int h, const float* __restrict__ w_a2, const float* __restrict__ b_a,
                                              bf16* __restrict__ qdf, bf16* __restrict__ kdntf, bf16* __restrict__ sc, float* __restrict__ ebl) {
    const int tid = threadIdx.x, wave = __builtin_amdgcn_readfirstlane(tid >> 6), lane = tid & 63, k = tid, kcol = h * DK + k;
    LAS float* AL = (LAS float*)(sm + GP_AL);
    if (tid < 256) { f32x4 a4 = {0.f, 0.f, 0.f, 0.f};
        if (!meta) a4 = *((const f32x4*)arow + tid);
        else { const int t = tid >> 2; if (t >= 48) a4 = *((const f32x4*)(MPROJ + (size_t)(t - 48) * MGIN + NQKVR) + (tid & 3)); }
        *((LAS f32x4*)AL + tid) = a4; }
    float w[16];
#pragma unroll
    for (int r = 0; r < 16; ++r) w[r] = w_a2[r * QK + kcol];
    const float ba = b_a[kcol];
    __syncthreads();
    float bc = 0.f;
    for (int g8 = 0; g8 < 8; ++g8) {
        float qv[8], kv[8];
#pragma unroll
        for (int e = 0; e < 8; ++e) { const int t = g8 * 8 + e;
            if (!meta) { qv[e] = bf2f(prow[(size_t)t * NQKVR + kcol]); kv[e] = bf2f(prow[(size_t)t * NQKVR + QK + kcol]); }
            else if (t >= 48) { qv[e] = MPROJ[(size_t)(t - 48) * MGIN + kcol]; kv[e] = MPROJ[(size_t)(t - 48) * MGIN + QK + kcol]; }
            else { qv[e] = 0.f; kv[e] = 0.f; } }
        unsigned kp[4];
#pragma unroll
        for (int e = 0; e < 8; ++e) { const int t = g8 * 8 + e;
            if (!meta || t >= 48) {
                float x = ba;
#pragma unroll
                for (int r4 = 0; r4 < 4; ++r4) { const f32x4 a4 = *((const LAS f32x4*)AL + t * 4 + r4); x += a4.x * w[4 * r4] + a4.y * w[4 * r4 + 1] + a4.z * w[4 * r4 + 2] + a4.w * w[4 * r4 + 3]; }
                const float ls = fminf(x, 0.f) - __logf(1.0f + __expf(-fabsf(x)));
                bc += ls * (1.0f / 16.0f); }
            const float eb = __expf(bc), en = 1.0f / eb;
            const unsigned qd = f2bf(qv[e] * eb * 0.04419417382415922f), kd = f2bf(kv[e] * en);
            *(LAS unsigned short*)(sm + GP_QD + t * GP_LD + k * 2) = (unsigned short)qd;
            *(LAS unsigned short*)(sm + GP_KDN + t * GP_LD + k * 2) = (unsigned short)kd;
            if (e & 1) kp[e >> 1] |= kd << 16; else kp[e >> 1] = kd; }
        { v4u o; o.x = kp[0]; o.y = kp[1]; o.z = kp[2]; o.w = kp[3];
          *(v4u*)(kdntf + ((size_t)(((k >> 5) * 4 + (g8 >> 1)) * 64 + (k & 31) + 32 * (g8 & 1))) * 8) = o; }
    }
    ebl[k] = __expf(bc);
    __syncthreads();
    const int r = lane & 31, hh = lane >> 5;
    if (wave < 4) {
        const int ti = wave & 1, tj = wave >> 1;
        f32x16 acc;
#pragma unroll
        for (int i = 0; i < 16; ++i) acc[i] = 0.f;
        const LAS unsigned char* pa = sm + GP_QD + (32 * ti + r) * GP_LD + 16 * hh; const LAS unsigned char* pb = sm + GP_KDN + (32 * tj + r) * GP_LD + 16 * hh;
#pragma unroll 8
        for (int kb = 0; kb < 32; ++kb) { const bf16x8 a = *(const LAS bf16x8*)(pa + kb * 32), b = *(const LAS bf16x8*)(pb + kb * 32); acc = MFMA32(a, b, acc); }
#pragma unroll
        for (int i = 0; i < 16; ++i) { const int ii = 32 * ti + (i & 3) + 8 * (i >> 2) + 4 * hh, jj = 32 * tj + r; sc[ii * 64 + jj] = (bf16)f2bf(jj <= ii ? acc[i] : 0.f); }
    } else {
        const int t2 = tid - 256;
#pragma unroll 4
        for (int n = 0; n < 16; ++n) { const int pi = t2 + 256 * n, f = pi >> 6, l = pi & 63, rr = l & 31, h2 = l >> 5, kt = f >> 2, s = (f >> 1) & 1, tt = f & 1;
            const LAS unsigned char* src = sm + GP_QD + (32 * tt + rr) * GP_LD + (32 * kt + 16 * s + 4 * h2) * 2;
            const v2u lo = *(const LAS v2u*)src, hi = *(const LAS v2u*)(src + 16);
            v4u o; o.x = lo.x; o.y = lo.y; o.z = hi.x; o.w = hi.y;
            *(v4u*)(qdf + (size_t)pi * 8) = o; }
    }
    __syncthreads();
}
__device__ __forceinline__ void gla_scan(LAS unsigned char* sm, const bf16* __restrict__ PROJ, const float* __restrict__ MPROJ, const bf16* __restrict__ QDF, const bf16* __restrict__ KDNTF, const bf16* __restrict__ SC,
                                         const float* __restrict__ EBL, const bf16* __restrict__ MQDF, const bf16* __restrict__ MKDNTF, const bf16* __restrict__ MSC, const float* __restrict__ MEBL,
                                         bf16* __restrict__ O, float* __restrict__ MO) {
    const int tid = threadIdx.x, wave = __builtin_amdgcn_readfirstlane(tid >> 6), lane = tid & 63, r = lane & 31, hh = lane >> 5, half = wave >> 2, js = wave & 3;
    const int sa_off = (r * 64 + 16 * js + 8 * hh) * 2;
    const int vt_ = lane, v8_ = wave * 8;
    const LAS unsigned char* vb0 = sm + GS_VT + (32 * half + r) * GS_VT_LD + 16 * hh;
    const LAS unsigned char* vb1 = sm + GS_VT + (32 * (half ^ 1) + r) * GS_VT_LD + 16 * hh;
    const LAS unsigned char* eb_rd = sm + GS_EB + (64 * wave + 4 * hh) * 4;
    LAS unsigned char* op_wr = sm + wave * 16384 + lane * 4;
    const int op_y0 = half * 4096, op_y1 = (half ^ 1) * 4096;
    const LAS unsigned char* op_rd = sm + (tid >> 4) * 256 + (tid & 15) * 16;
    const int red_t = 8 * ((tid >> 6) & 3) + 4 * ((tid >> 3) & 1) + ((tid >> 4) & 3), red_v = 32 * ((tid >> 8) & 1) + 4 * (tid & 7);
    for (int u0 = blockIdx.x; u0 < 256; u0 += gridDim.x) {
        const int u = gridDim.x == 256 ? ((u0 & 7) * 2 + (u0 >> 7)) * 16 + ((u0 >> 3) & 15) : u0;
        const int b = u >> 6, h = (u >> 4) & 3, vs = u & 15;
        f32x16 S00, S01, S10, S11;
#pragma unroll
        for (int i = 0; i < 16; ++i) { S00[i] = 0.f; S01[i] = 0.f; S10[i] = 0.f; S11[i] = 0.f; }
        bf16x8 qa[8], ka[8], sa[2]; v4u vreg; f32x4 ereg = {0.f, 0.f, 0.f, 0.f};
        const char* const mqf = (const char*)(MQDF + (size_t)h * GLA_ITEM_FR); const char* const mkf = (const char*)(MKDNTF + (size_t)h * GLA_ITEM_FR);
        const char* const msc = (const char*)(MSC + (size_t)h * 4096); const float* const meb = MEBL + h * DK;
#define GS_ITEM(c) const size_t it_ = ((size_t)b * 64 + (size_t)((c) > 0 ? (c) - 1 : 0)) * GH + h; \
            const char* qf_ = (c) == 0 ? mqf : (const char*)(QDF + it_ * GLA_ITEM_FR); const char* kf_ = (c) == 0 ? mkf : (const char*)(KDNTF + it_ * GLA_ITEM_FR); \
            const char* sc_ = (c) == 0 ? msc : (const char*)(SC + it_ * 4096); const float* eb_ = (c) == 0 ? meb : EBL + it_ * DK; (void)qf_; (void)kf_; (void)sc_; (void)eb_
#define GS_OPQ(name, val) int name##_i = (val); asm volatile("" : "+v"(name##_i)); const size_t name = (size_t)(unsigned)name##_i
#define GS_LOAD_Q(c) do { GS_ITEM(c); const char* qb_ = qf_ + wave * 8192; GS_OPQ(l16_, lane * 16); GS_OPQ(sao_, (int)sa_off); \
            _Pragma("unroll") for (int f = 0; f < 8; ++f) qa[f] = *(const bf16x8*)(qb_ + f * 1024 + l16_); \
            sa[0] = *(const bf16x8*)(sc_ + sao_); sa[1] = *(const bf16x8*)(sc_ + 4096 + sao_); } while (0)
#define GS_LOAD_K(c) do { GS_ITEM(c); const char* kb_ = kf_ + wave * 8192; GS_OPQ(l16_, lane * 16); \
            _Pragma("unroll") for (int j = 0; j < 8; ++j) ka[j] = *(const bf16x8*)(kb_ + j * 1024 + l16_); } while (0)
#define GS_LOAD_V(c) do { GS_ITEM(c); \
            if (tid < 128) { GS_OPQ(eo_, tid * 16); ereg = *(const f32x4*)((const char*)eb_ + eo_); } \
            if ((c) == 0) { if (vt_ >= 48) { GS_OPQ(vo_, ((vt_ - 48) * MGIN + v8_) * 4); const float* vp = (const float*)((const char*)(MPROJ + 2 * QK + h * DV + vs * 64) + vo_); const f32x4 x0 = *(const f32x4*)vp, x1 = *(const f32x4*)(vp + 4); \
                                  vreg.x = pk2(x0.x, x0.y); vreg.y = pk2(x0.z, x0.w); vreg.z = pk2(x1.x, x1.y); vreg.w = pk2(x1.z, x1.w); } else { vreg = (v4u){0u, 0u, 0u, 0u}; } } \
            else { GS_OPQ(vo_, (vt_ * NQKVR + v8_) * 2); vreg = *(const v4u*)((const char*)(PROJ + ((size_t)b * SEQ + (size_t)(((c) - 1) * 64)) * NQKVR + 2 * QK + h * DV + vs * 64) + vo_); } } while (0)
#define GS_STEP1() do { _Pragma("unroll") for (int e = 0; e < 8; ++e) { const unsigned wv = vreg[e >> 1]; *(LAS unsigned short*)(sm + GS_VT + (v8_ + e) * GS_VT_LD + vt_ * 2) = (unsigned short)((e & 1) ? (wv >> 16) : (wv & 0xffffu)); } \
            if (tid < 128) *((LAS f32x4*)(sm + GS_EB) + tid) = ereg; } while (0)
        GS_LOAD_V(0); GS_LOAD_Q(0);
        GS_STEP1();
#pragma unroll 1
        for (int c = 0; c <= 64; ++c) {
            __syncthreads();
            GS_LOAD_K(c);
            if (c < 64) GS_LOAD_V(c + 1);
            __builtin_amdgcn_sched_barrier(0);
#define GS_OHALF(Sa, Sb, vbp, sfrag, tsel, opy) do { f32x16 o0, o1; _Pragma("unroll") for (int i = 0; i < 16; ++i) { o0[i] = 0.f; o1[i] = 0.f; } \
              _Pragma("unroll") for (int s = 0; s < 2; ++s) { const bf16x8 sb = pack_step(Sa, s); o0 = MFMA32(qa[s * 2 + 0], sb, o0); o1 = MFMA32(qa[s * 2 + 1], sb, o1); } \
              _Pragma("unroll") for (int s = 0; s < 2; ++s) { const bf16x8 sb = pack_step(Sb, s); o0 = MFMA32(qa[4 + s * 2 + 0], sb, o0); o1 = MFMA32(qa[4 + s * 2 + 1], sb, o1); } \
              { const bf16x8 vI = *(const LAS bf16x8*)((vbp) + js * 32); if (tsel == 0) o0 = MFMA32(sfrag, vI, o0); else o1 = MFMA32(sfrag, vI, o1); } \
              _Pragma("unroll") for (int i = 0; i < 16; ++i) { *(LAS float*)(op_wr + (opy) + i * 256) = o0[i]; *(LAS float*)(op_wr + 8192 + (opy) + i * 256) = o1[i]; } \
              __builtin_amdgcn_sched_barrier(0); } while (0)
            GS_OHALF(S00, S10, vb0, sa[0], 0, op_y0);
            GS_OHALF(S01, S11, vb1, sa[1], 1, op_y1);
            {
              bf16x8 vB0[4], vB1[4];
#pragma unroll
              for (int ts = 0; ts < 4; ++ts) { vB0[ts] = *(const LAS bf16x8*)(vb0 + ts * 32); vB1[ts] = *(const LAS bf16x8*)(vb1 + ts * 32); }
              f32x4 ea[4], ec[4];
#define GS_EBLD(e, kt) do { _Pragma("unroll") for (int g4 = 0; g4 < 4; ++g4) e[g4] = *(const LAS f32x4*)(eb_rd + (32 * (kt) + 8 * g4) * 4); } while (0)
#define GS_EBMUL(Sx, e) do { _Pragma("unroll") for (int g4 = 0; g4 < 4; ++g4) { Sx[4 * g4 + 0] *= e[g4].x; Sx[4 * g4 + 1] *= e[g4].y; Sx[4 * g4 + 2] *= e[g4].z; Sx[4 * g4 + 3] *= e[g4].w; } \
                asm volatile("" : "+v"(Sx));     } while (0)
              GS_EBLD(ea, 0); GS_EBLD(ec, 1);
#pragma unroll
              for (int ts = 0; ts < 4; ++ts) {
                S00 = MFMA32(ka[ts], vB0[ts], S00); S01 = MFMA32(ka[ts], vB1[ts], S01); S10 = MFMA32(ka[4 + ts], vB0[ts], S10); S11 = MFMA32(ka[4 + ts], vB1[ts], S11); }
              __builtin_amdgcn_sched_barrier(0);
              if (c < 64) GS_LOAD_Q(c + 1);
              __builtin_amdgcn_sched_barrier(0);
              GS_EBMUL(S00, ea); GS_EBMUL(S01, ea); __builtin_amdgcn_sched_barrier(0);
              GS_EBMUL(S10, ec); GS_EBMUL(S11, ec); __builtin_amdgcn_sched_barrier(0);
#undef GS_EBLD
#undef GS_EBMUL
            }
            __syncthreads();
            if (c < 64) GS_STEP1();
            { int lo = (red_t * GV + red_v) * 2; asm volatile("" : "+v"(lo));
              const char* const ob = (const char*)(O + ((size_t)b * SEQ + (size_t)((c > 0 ? c - 1 : 0) * 64)) * GV + h * DV + vs * 64);
#pragma unroll
              for (int p = 0; p < 2; ++p) {
                f32x4 s4 = *(const LAS f32x4*)(op_rd + p * 8192);
#pragma unroll
                for (int w8 = 1; w8 < 8; ++w8) { const f32x4 x = *(const LAS f32x4*)(op_rd + w8 * 16384 + p * 8192); s4.x += x.x; s4.y += x.y; s4.z += x.z; s4.w += x.w; }
                if (p == 1 && c == 0 && b == 0 && red_t >= 16) *(f32x4*)(MO + (size_t)(red_t - 16) * GV + h * DV + vs * 64 + red_v) = s4;
                { v2u w; w.x = pk2(s4.x, s4.y); w.y = pk2(s4.z, s4.w); *(v2u*)(ob + (size_t)p * (32 * GV * 2) + lo) = w; } } }
            __builtin_amdgcn_sched_barrier(0);
        }
#undef GS_ITEM
#undef GS_LOAD_Q
#undef GS_LOAD_K
#undef GS_LOAD_V
#undef GS_OPQ
#undef GS_OHALF
#undef GS_STEP1
        __syncthreads();
    }
}

template <bool OBF>
__device__ __forceinline__ void gate_item(const void* orow  , const float* __restrict__ hn, f32x4 (&rv)[4], bf16* og, int lane) {
    f32x4 v[4]; float s = 0.f;
#pragma unroll
    for (int j = 0; j < 4; ++j) {
        if (OBF) { const v2u w = *((const v2u*)orow + lane + 64 * j); v[j] = (f32x4){bflo(w.x), bfhi(w.x), bflo(w.y), bfhi(w.y)}; }
        else v[j] = *((const f32x4*)orow + lane + 64 * j);
        s += (v[j].x * v[j].x + v[j].y * v[j].y) + (v[j].z * v[j].z + v[j].w * v[j].w); }
    const float rs = 1.0f / sqrtf(wave_sum(s) * (1.0f / DV) + EPS);
#pragma unroll
    for (int j = 0; j < 4; ++j) { const f32x4 g = *((const f32x4*)hn + lane + 64 * j);
        v2u w; w.x = pk2(v[j].x * rs * g.x * silu_f(rv[j].x), v[j].y * rs * g.y * silu_f(rv[j].y)); w.y = pk2(v[j].z * rs * g.z * silu_f(rv[j].z), v[j].w * rs * g.w * silu_f(rv[j].w));
        *((v2u*)og + lane + 64 * j) = w; }
}

struct Args { const float* in[16]; float* out; unsigned char* ws; int ph_lo, ph_hi, li, pad; };
enum { I_X = 0, I_META, I_NMIX, I_NFFN, I_GWIN, I_GWA2, I_GBA, I_GHN, I_GWOUT, I_CWIN, I_CW, I_CWOUT, I_FGATE, I_FUP, I_FDOWN, I_NFINAL };

__global__ void __launch_bounds__(NWAVES * 64, 2) trunk_fwd(Args args) {
    extern __shared__ __attribute__((aligned(16))) unsigned char lds_raw[];
    LAS unsigned char* lds = (LAS unsigned char*)lds_raw;
    volatile LAS unsigned* MISC = (volatile LAS unsigned*)(lds + MISC_OFF);
    const int tid = threadIdx.x, lane = tid & 63, wave = __builtin_amdgcn_readfirstlane(tid >> 6);
    const int G = gridDim.x, bx = blockIdx.x;
    const int gw = bx * NWAVES + wave, NGW = G * NWAVES;
    unsigned char* ws = args.ws;
    unsigned* ctl = (unsigned*)(ws + WS_CTL);
    float* SS = (float*)ctl + CW_SS; float* MSS = (float*)ctl + CW_MSS; float* SSP = (float*)(ws + WS_SSP); constexpr size_t SSP_N = (size_t)64 * 16 * 256 * 4;
    const float* x = args.in[I_X]; float* out = args.out;
    bf16* W_GIN = (bf16*)(ws + WS_WGIN); bf16* W_GOUT = (bf16*)(ws + WS_WGOUT); bf16* W_GU0 = (bf16*)(ws + WS_WGU0); bf16* W_DN0 = (bf16*)(ws + WS_WDN0);
    bf16* W_CIN = (bf16*)(ws + WS_WCIN); bf16* W_COUT = (bf16*)(ws + WS_WCOUT); bf16* W_GU1 = (bf16*)(ws + WS_WGU1); bf16* W_DN1 = (bf16*)(ws + WS_WDN1);
    bf16* XB = (bf16*)(ws + WS_XB); bf16* OG = (bf16*)(ws + WS_OG); bf16* PROJ = (bf16*)(ws + WS_PROJ); bf16* ACT = PROJ;
    bf16* O = (bf16*)(ws + WS_O); float* ALOW = (float*)(ws + WS_ALOW);
    bf16* QDF = (bf16*)(ws + WS_QDF); bf16* KDNTF = (bf16*)(ws + WS_KDNTF); bf16* SC = (bf16*)(ws + WS_SC); float* EBL = (float*)(ws + WS_EBL);
    unsigned char* mt = ws + WS_META;
    bf16* MXB = (bf16*)(mt + MT_XB); float* MPROJ = (float*)(mt + MT_PROJ); float* MO = (float*)(mt + MT_O); bf16* MOG = (bf16*)(mt + MT_OG); float* MH = (float*)(mt + MT_H);
    bf16* MACT = (bf16*)(mt + MT_ACT); float* ZM = (float*)(mt + MT_Z);
    bf16* MQDF = (bf16*)(mt + MT_QDF); bf16* MKDNTF = (bf16*)(mt + MT_KDNTF); bf16* MSC = (bf16*)(mt + MT_SC); float* MEBL = (float*)(mt + MT_EBL);

    for (int u = tid; u < 1024 / 4; u += NWAVES * 64) ((LAS unsigned*)(lds + LDSCTL_OFF))[u] = 0u;
    __syncthreads();
    const int lo = args.ph_lo, hi = args.ph_hi;
    XcdBarrier bar; bar.bar = ctl + CW_BAR + args.li * XCD_BAR_WORDS; bar.x = 0; bar.st = nullptr;
    if (hi - lo > 1) bar = xcd_barrier_post(ctl + CW_BAR + args.li * XCD_BAR_WORDS, MISC + 8);
#ifndef ONLY_PHASE
#define ONLY_PHASE -1
#endif
#define IN(k) (lo <= (k) && (k) < hi && (ONLY_PHASE < 0 || (k) == ONLY_PHASE))
#define SEAM(k) do { if (IN(k) && IN((k) + 1)) xcd_barrier(bar); } while (0)

    if (IN(0)) {
        LAS float* scr = (LAS float*)(lds + RING_OFF + wave * 16384);
        cvt_task<0>(args.in[I_GWIN], D, GIN, GIN, args.in[I_NMIX], W_GIN, scr, gw, NGW, lane);
        cvt_task<0>(args.in[I_GWOUT], GV, D, D, nullptr, W_GOUT, scr, gw, NGW, lane);
        cvt_task<1>(args.in[I_FGATE], D, FF, FF, args.in[I_NFFN], W_GU0, scr, gw, NGW, lane);
        cvt_task<2>(args.in[I_FUP], D, FF, FF, args.in[I_NFFN], W_GU0, scr, gw, NGW, lane);
        cvt_task<0>(args.in[I_FDOWN], FF, D, D, nullptr, W_DN0, scr, gw, NGW, lane);
        cvt_task<0>(args.in[I_CWIN], D, NQKVR, NQKVR, args.in[I_NMIX] + D, W_CIN, scr, gw, NGW, lane);
        cvt_task<0>(args.in[I_CWOUT], D, D, D, nullptr, W_COUT, scr, gw, NGW, lane);
        cvt_task<1>(args.in[I_FGATE] + (size_t)D * FF, D, FF, FF, args.in[I_NFFN] + D, W_GU1, scr, gw, NGW, lane);
        cvt_task<2>(args.in[I_FUP] + (size_t)D * FF, D, FF, FF, args.in[I_NFFN] + D, W_GU1, scr, gw, NGW, lane);
        cvt_task<0>(args.in[I_FDOWN] + (size_t)FF * D, FF, D, D, nullptr, W_DN1, scr, gw, NGW, lane);
        for (int blk = bx; blk < M / 64; blk += G)
            for (int i = 0; i < 8; ++i) { const int m = blk * 64 + wave * 8 + i; row_to_bf16_ss(x + (size_t)m * D, XB + (size_t)m * D, SS + m, lane); }
        if (bx == 0) for (int i = 0; i < 2; ++i) { const int m = wave * 2 + i; row_to_bf16_ss(args.in[I_META] + (size_t)m * D, MXB + (size_t)m * D, MSS + m, lane); }
        for (int oc = bx; oc < NMETA * GR; oc += G) {
            const int r = oc >> 4, c = oc & 15; const float* mr = args.in[I_META] + (size_t)r * D; const float* gm = args.in[I_NMIX]; const float* wi = args.in[I_GWIN] + NQKVR + c;
            float ssq = 0.f, acc = 0.f;
#pragma unroll
            for (int j = 0; j < 8; ++j) { const int k = tid + 512 * j; const float xv = mr[k]; ssq += xv * xv; acc += xv * gm[k] * wi[(size_t)k * GIN]; }
            ssq = wave_sum(ssq); acc = wave_sum(acc);
            LAS float* rd = (LAS float*)(lds + RING_OFF + 8 * 16384);
            __syncthreads(); if (lane == 0) { rd[wave] = ssq; rd[8 + wave] = acc; } __syncthreads();
            if (tid == 0) { float s2 = 0.f, a2 = 0.f; for (int w = 0; w < 8; ++w) { s2 += rd[w]; a2 += rd[8 + w]; } MPROJ[(size_t)r * MGIN + NQKVR + c] = a2 * rstd_of(s2); } }
    }
    SEAM(0);

    if (IN(1)) {
        { TE_ALow e{ALOW, SS}; thin_gemm16<false>(lds + RING_OFF, W_GIN + (size_t)NQKVR * D, XB, D, M / 16, 0, e, bx, G); }
        { LAS float* rt = (LAS float*)(lds + RING_OFF + 16384); thin_row_rstd(rt, args.in[I_META]); TE_MProj e{MPROJ, rt}; thin_gemm16<false>(lds + RING_OFF, MXB, W_GIN, D, NQKVR / 16, 0, e, bx, G); }
        pg8::Gemm g{XB, W_GIN, M, NQKVR, D}; pg8::RstdOrder S; S.init(M, NQKVR, G, bx); S.ssp = nullptr; S.ss0 = SS; S.npn = 0; S.cnt = 0;
        pg8::EpiScaleBf16 E{PROJ, NQKVR, 0};
        pg8::gemm_phase<pg8::EpiScaleBf16, pg8::RstdOrder, true, true>(lds + RING_OFF, g, S, E);
    }
    SEAM(1);

    if (IN(2)) {
        LAS unsigned char* sm = lds + RING_OFF;
        if (bx < GH) gla_prep_item(sm, true, PROJ, ALOW, MPROJ, bx, args.in[I_GWA2], args.in[I_GBA], MQDF + (size_t)bx * GLA_ITEM_FR, MKDNTF + (size_t)bx * GLA_ITEM_FR, MSC + (size_t)bx * 4096, MEBL + bx * DK);
        for (int it = bx; it < NB * 64 * GH; it += G) { const int h = it & 3; const size_t m0 = (size_t)(it >> 2) * 64;
            gla_prep_item(sm, false, PROJ + m0 * NQKVR, ALOW + m0 * 16, MPROJ, h, args.in[I_GWA2], args.in[I_GBA], QDF + (size_t)it * GLA_ITEM_FR, KDNTF + (size_t)it * GLA_ITEM_FR, SC + (size_t)it * 4096, EBL + (size_t)it * DK); }
    }
    SEAM(2);

#ifndef NO_SCAN
    if (IN(3)) gla_scan(lds + RING_OFF, PROJ, MPROJ, QDF, KDNTF, SC, EBL, MQDF, MKDNTF, MSC, MEBL, O, MO);
#endif
    SEAM(3);

    if (IN(4)) {
        const float* hn = args.in[I_GHN];
        for (int it = gw; it < M * GH; it += NGW) { const int m = it >> 2, h = it & 3; f32x4 rv[4];
            const v2u* rp = (const v2u*)(PROJ + (size_t)m * NQKVR + 2 * QK + GV + h * DV);
#pragma unroll
            for (int j = 0; j < 4; ++j) { const v2u w = rp[lane + 64 * j]; rv[j] = (f32x4){bflo(w.x), bfhi(w.x), bflo(w.y), bfhi(w.y)}; }
            gate_item<true>(O + (size_t)m * GV + h * DV, hn, rv, OG + (size_t)m * GV + h * DV, lane); }
        if (gw < NMETA * GH) { const int m = gw >> 2, h = gw & 3; f32x4 rv[4];
#pragma unroll
            for (int j = 0; j < 4; ++j) rv[j] = *((const f32x4*)(MPROJ + (size_t)m * MGIN + 2 * QK + GV + h * DV) + lane + 64 * j);
            gate_item<false>(MO + (size_t)m * GV + h * DV, hn, rv, MOG + (size_t)m * GV + h * DV, lane); }
    }
    SEAM(4);

    if (IN(5)) {
        { TE_MResid e{args.in[I_META], MH, MXB, MSS + MSS_STRIDE}; thin_gemm16<false>(lds + RING_OFF, MOG, W_GOUT, GV, D / 16, 0, e, bx, G); }
        pg8::Gemm g{OG, W_GOUT, M, D, GV}; pg8::StaticOrder S; S.init(M, D, G, bx);
        pg8::EpiResid<false> E{x, XB, SSP, D};
        pg8::gemm_phase<pg8::EpiResid<false>, pg8::StaticOrder, true, true>(lds + RING_OFF, g, S, E);
    }
    SEAM(5);

    if (IN(6)) {
        const bool thin_in_tail = G == 256;
        if (!thin_in_tail) { LAS float* rt = (LAS float*)(lds + RING_OFF + 16384); thin_row_rstd(rt, MH); TE_MSwiGLU e{MACT, rt}; thin_gemm16<true>(lds + RING_OFF, MXB, W_GU0, D, FF / 16, 128, e, bx, G); }
        pg8::Gemm g{XB, W_GU0, M, NGU, D}; pg8::RstdOrder S; S.init(M, NGU, G, bx); S.ssp = SSP; S.ss0 = nullptr; S.npn = D / 256; S.cnt = 0;
        pg8::EpiSwiGLU E{ACT, FF, 0};
        pg8::gemm_phase<pg8::EpiSwiGLU, pg8::RstdOrder, true, true>(lds + RING_OFF, g, S, E);
        if (thin_in_tail && bx >= 128) { __syncthreads();
            LAS float* rt = (LAS float*)(lds + RING_OFF + 16384); thin_row_rstd(rt, MH); TE_MSwiGLU e{MACT, rt}; thin_gemm16<true>(lds + RING_OFF, MXB, W_GU0, D, FF / 16, 128, e, bx - 128, 128); }
    }
    SEAM(6);

    if (IN(7)) {
        { TE_MResid e{MH, MH, MXB, MSS + 2 * MSS_STRIDE}; thin_gemm16<false>(lds + RING_OFF, MACT, W_DN0, FF, D / 16, 0, e, bx, G); }
        pg8::Gemm g{ACT, W_DN0, M, D, FF}; pg8::StaticOrderPN S; S.init(M, D, G, bx);
        pg8::EpiResid<true> E{nullptr, XB, SSP + SSP_N, D};
        pg8::gemm_phase<pg8::EpiResid<true>, pg8::StaticOrderPN, true, true>(lds + RING_OFF, g, S, E);
    }
    SEAM(7);

    if (IN(8)) {
        { LAS float* rt = (LAS float*)(lds + RING_OFF + 16384); thin_row_rstd(rt, MH); TE_MConvZ e{ZM, rt}; thin_gemm16<true>(lds + RING_OFF, MXB, W_CIN, D, D / 16, 4096, e, bx, G); }
        pg8::Gemm g{XB, W_CIN, M, NQKVR, D}; pg8::RstdOrder S; S.init(M, NQKVR, G, bx); S.ssp = SSP + SSP_N; S.ss0 = nullptr; S.npn = D / 256; S.cnt = 0;
        pg8::EpiScaleBf16 E{PROJ, NQKVR, 0};
        pg8::gemm_phase<pg8::EpiScaleBf16, pg8::RstdOrder, true, true>(lds + RING_OFF, g, S, E);
    }
    SEAM(8);

    if (IN(9)) {
        const float* cw = args.in[I_CW];
        const int c0 = tid * 8;
        float w0[8], w1[8], w2[8];
#pragma unroll
        for (int j = 0; j < 8; ++j) { w0[j] = cw[c0 + j]; w1[j] = cw[D + c0 + j]; w2[j] = cw[2 * D + c0 + j]; }
        for (int run = bx; run < M / 64; run += G) {
            const int m0 = run * 64, s0 = m0 & (SEQ - 1);
            float z1[8], z2[8];
            if (s0 == 0) {
#pragma unroll
                for (int j = 0; j < 8; ++j) { z2[j] = ZM[c0 + j]; z1[j] = ZM[D + c0 + j]; }
            } else {
                const v4u cg2 = *(const v4u*)(PROJ + (size_t)(m0 - 2) * NQKVR + D + c0), u2 = *(const v4u*)(PROJ + (size_t)(m0 - 2) * NQKVR + 2 * D + c0);
                const v4u cg1 = *(const v4u*)(PROJ + (size_t)(m0 - 1) * NQKVR + D + c0), u1 = *(const v4u*)(PROJ + (size_t)(m0 - 1) * NQKVR + 2 * D + c0);
#pragma unroll
                for (int j = 0; j < 4; ++j) { z2[2 * j] = bflo(cg2[j]) * bflo(u2[j]); z2[2 * j + 1] = bfhi(cg2[j]) * bfhi(u2[j]); z1[2 * j] = bflo(cg1[j]) * bflo(u1[j]); z1[2 * j + 1] = bfhi(cg1[j]) * bfhi(u1[j]); }
            }
#pragma unroll 4
            for (int rr = 0; rr < 64; ++rr) {
                const bf16* row = PROJ + (size_t)(m0 + rr) * NQKVR + c0;
                const v4u bg = *(const v4u*)row, cg = *(const v4u*)(row + D), uu = *(const v4u*)(row + 2 * D);
                float z[8], y[8];
#pragma unroll
                for (int j = 0; j < 4; ++j) { z[2 * j] = bflo(cg[j]) * bflo(uu[j]); z[2 * j + 1] = bfhi(cg[j]) * bfhi(uu[j]); }
#pragma unroll
                for (int j = 0; j < 8; ++j) { const float cv = w2[j] * z[j] + w1[j] * z1[j] + w0[j] * z2[j]; const float bgf = (j & 1) ? bfhi(bg[j >> 1]) : bflo(bg[j >> 1]); y[j] = bgf * cv; z2[j] = z1[j]; z1[j] = z[j]; }
                v4u o; o.x = pk2(y[0], y[1]); o.y = pk2(y[2], y[3]); o.z = pk2(y[4], y[5]); o.w = pk2(y[6], y[7]);
                *(v4u*)(OG + (size_t)(m0 + rr) * D + c0) = o;
            }
        }
    }
    SEAM(9);

    if (IN(10)) {
        pg8::Gemm g{OG, W_COUT, M, D, D}; pg8::StaticOrder S; S.init(M, D, G, bx);
        pg8::EpiResid<true> E{nullptr, XB, SSP + 2 * SSP_N, D};
        pg8::gemm_phase<pg8::EpiResid<true>, pg8::StaticOrder, true, true>(lds + RING_OFF, g, S, E);
    }
    SEAM(10);

    if (IN(11)) {
        pg8::Gemm g{XB, W_GU1, M, NGU, D}; pg8::RstdOrder S; S.init(M, NGU, G, bx); S.ssp = SSP + 2 * SSP_N; S.ss0 = nullptr; S.npn = D / 256; S.cnt = 0;
        pg8::EpiSwiGLU E{ACT, FF, 0};
        pg8::gemm_phase<pg8::EpiSwiGLU, pg8::RstdOrder, true, true>(lds + RING_OFF, g, S, E);
    }
    SEAM(11);

    if (IN(12)) {
        pg8::Gemm g{ACT, W_DN1, M, D, FF}; pg8::StaticOrderPN S; S.init(M, D, G, bx);
        pg8::EpiResid<true> E{nullptr, XB, SSP, D};
        pg8::gemm_phase<pg8::EpiResid<true>, pg8::StaticOrderPN, true, true>(lds + RING_OFF, g, S, E);
    }
    SEAM(12);

    if (IN(13)) {
        const float* gf = args.in[I_NFINAL];
        bool bad = false;
        for (int r = 0; r < N_PHASES; ++r) bad |= __hip_atomic_load(ctl + CW_BAR + r * XCD_BAR_WORDS + XB_TMO, __ATOMIC_RELAXED, __HIP_MEMORY_SCOPE_AGENT) != 0u;
        for (int m = gw; m < M; m += NGW) { const v4u* xr = (const v4u*)(XB + (size_t)m * D) + lane; f32x4* row = (f32x4*)(out + (size_t)m * D) + 2 * lane; v4u q[8]; float ssq = 0.f;
#pragma unroll
            for (int j = 0; j < 8; ++j) { q[j] = xr[64 * j];
#pragma unroll
                for (int e = 0; e < 4; ++e) { const float lo = bflo(q[j][e]), hi = bfhi(q[j][e]); ssq += lo * lo + hi * hi; } }
            const float rs = bad ? __builtin_nanf("") : rstd_of(wave_sum(ssq));
#pragma unroll
            for (int j = 0; j < 8; ++j) { const f32x4 g0 = *((const f32x4*)gf + 2 * lane + 128 * j), g1 = *((const f32x4*)gf + 2 * lane + 128 * j + 1);
                f32x4 o0, o1; o0.x = bflo(q[j].x) * rs * g0.x; o0.y = bfhi(q[j].x) * rs * g0.y; o0.z = bflo(q[j].y) * rs * g0.z; o0.w = bfhi(q[j].y) * rs * g0.w;
                o1.x = bflo(q[j].z) * rs * g1.x; o1.y = bfhi(q[j].z) * rs * g1.y; o1.z = bflo(q[j].w) * rs * g1.z; o1.w = bfhi(q[j].w) * rs * g1.w;
                row[128 * j] = o0; row[128 * j + 1] = o1; } }
    }
#undef IN
#undef SEAM
}

extern "C" void kernel_launch(void* const* d_in, const int* in_sizes, int n_in, void* d_out, int out_size, void* d_ws, size_t ws_size, hipStream_t stream) {
    static int grid = 0;
    if (grid == 0) {
        if (n_in != 16 || in_sizes[0] != M * D || out_size != M * D || ws_size < WS_END) { fprintf(stderr, "kernel_launch: unexpected problem (n_in %d, in0 %d, out %d, ws %zu < %zu)\n", n_in, n_in > 0 ? in_sizes[0] : -1, out_size, ws_size, (size_t)WS_END); grid = -1; return; }
        int dev = 0, cus = 0, per_cu = 0;
        if (hipGetDevice(&dev) != hipSuccess || hipDeviceGetAttribute(&cus, hipDeviceAttributeMultiprocessorCount, dev) != hipSuccess) { grid = -1; return; }
        if (hipFuncSetAttribute((const void*)trunk_fwd, hipFuncAttributeMaxDynamicSharedMemorySize, LDS_BYTES) != hipSuccess) { fprintf(stderr, "kernel_launch: hipFuncSetAttribute failed\n"); grid = -1; return; }
        if (hipOccupancyMaxActiveBlocksPerMultiprocessor(&per_cu, (const void*)trunk_fwd, NWAVES * 64, LDS_BYTES) != hipSuccess || per_cu < 1)
            fprintf(stderr, "kernel_launch: note: occupancy query reports %d workgroups per CU\n", per_cu);
        (void)hipGetLastError();
        grid = cus;
    }
    if (grid < 0) return;
#if DIAG_POISON
    (void)hipMemsetAsync((char*)d_ws + CTL_ZERO_BYTES, 0xAA, WS_END - CTL_ZERO_BYTES, stream);
    (void)hipMemsetAsync(d_out, 0xAA, (size_t)M * D * 4, stream);
#endif
    if (hipMemsetAsync((char*)d_ws + WS_CTL, 0, CTL_ZERO_BYTES, stream) != hipSuccess) { fprintf(stderr, "kernel_launch: memset failed\n"); return; }
    Args a{};
    for (int i = 0; i < 16; ++i) a.in[i] = (const float*)d_in[i];
    a.out = (float*)d_out; a.ws = (unsigned char*)d_ws;
    int li = 0;
    for (int p0 = 0; p0 < N_PHASES; ++li) {
        int p1 = p0 + 1; while (p1 < N_PHASES && !((MK_CUTS >> (p1 - 1)) & 1u)) ++p1;
        a.ph_lo = p0; a.ph_hi = p1; a.li = li; p0 = p1;
        hipLaunchKernelGGL(trunk_fwd, dim3(grid), dim3(NWAVES * 64), LDS_BYTES, stream, a);
        const hipError_t le = hipPeekAtLastError();
        if (le != hipSuccess) { fprintf(stderr, "kernel_launch: launch %d failed: %s\n", li, hipGetErrorName(le)); break; }
    }
}
```

```cpp
#include <hip/hip_runtime.h>
#include <cstdio>
#include <cstdint>
namespace pg8 {
#define PG8_LAS __attribute__((address_space(3)))
typedef unsigned short bf16_t;
typedef short bf16x8 __attribute__((ext_vector_type(8)));
typedef float f32x4 __attribute__((ext_vector_type(4)));
typedef unsigned u32x4 __attribute__((ext_vector_type(4)));
constexpr int BM = 256, BK = 64, HALF = 128, HTB = HALF * BK * 2  , STAGE_BYTES = 8 * HTB, NXCD = 8, WGM = 8;

__host__ __device__ __forceinline__ int lds_byte(int r, int c) { const int st = (r >> 4) * 2 + (c >> 5), rr = r & 15, cc = c & 31, ob = rr * 64 + cc * 2; return st * 1024 + (ob ^ (((ob >> 9) & 1) << 5)); }
__host__ __device__ __forceinline__ void stage_rc(int b, int& R, int& C) { const int st = b / 1024, sb = b % 1024, swz = sb ^ (((sb >> 9) & 1) << 5); R = (st >> 1) * 16 + swz / 64; C = (st & 1) * 32 + (swz % 64) / 2; }
__host__ __device__ __forceinline__ int perm32(int rho) { const int n = rho >> 4, i = rho & 15; return 8 * (i >> 2) + 4 * n + (i & 3); }

struct Unit { int pm, pn; };
struct Gemm { const bf16_t* A; const bf16_t* Bt; int M, N, K; };

struct StaticOrder {
    int nM, nN, nwg, G, c;
    __host__ __device__ void init(int M, int N, int G_, int c_) { nM = M / BM; nN = N / BM; nwg = nM * nN; G = G_; c = c_; }
    __host__ __device__ bool next(int i, Unit& u) const {
        const long L = (long)i * G + c; if (L >= nwg) return false;
        int wgid = (int)L; { const int q = nwg / NXCD, r = nwg % NXCD, xcd = wgid % NXCD, off = wgid / NXCD; wgid = (xcd < r ? xcd * (q + 1) : r * (q + 1) + (xcd - r) * q) + off; }
        const int nig = WGM * nN, gid = wgid / nig, fm = gid * WGM, gsz = (nM - fm) < WGM ? (nM - fm) : WGM;
        u.pm = fm + ((wgid % nig) % gsz); u.pn = (wgid % nig) / gsz; return true;
    }
    __device__ __forceinline__ void a_ready(const Unit&) const {}
    __device__ __forceinline__ void done(const Unit&) const {}
    __device__ __forceinline__ void after_epi(const Unit&) const {}
};


struct StaticOrderPN : StaticOrder {
    __host__ __device__ bool next(int i, Unit& u) const {
        const long L = (long)i * G + c; if (L >= nwg) return false;
        int wgid = (int)L; { const int q = nwg / NXCD, r = nwg % NXCD, xcd = wgid % NXCD, off = wgid / NXCD; wgid = (xcd < r ? xcd * (q + 1) : r * (q + 1) + (xcd - r) * q) + off; }
        const int nig = WGM * nN, gid = wgid / nig, fm = gid * WGM, idx = wgid % nig;
        u.pm = fm + idx / nN; u.pn = idx % nN; return true;
    }
};

__device__ __forceinline__ unsigned cvt_pk_bf16(float lo, float hi) { unsigned r; asm volatile("v_cvt_pk_bf16_f32 %0, %1, %2" : "=v"(r) : "v"(lo), "v"(hi)); return r; }
__device__ __forceinline__ float rstd_of(float ss) { return 1.0f / sqrtf(ss * (1.0f / 4096.0f) + 1e-6f); }
__device__ __forceinline__ float silu_f(float x) { return x * __builtin_amdgcn_rcpf(1.0f + __expf(-x)); }

struct EpiScaleBf16 {
    static constexpr bool PERM = true, AFTER_DRAIN = false;
    bf16_t* O; int ldc; mutable int cnt;
    __device__ __forceinline__ void operator()(const f32x4 (&acc)[2][2][4][2], const Unit& u, int wr, int wc, int fr, int fq) const {
        const int row0 = u.pm * BM + wr * 64 + fr, col0 = u.pn * BM + wc * 32 + 8 * fq; const PG8_LAS float* tb = (const PG8_LAS float*)(unsigned)131072 + (cnt & 1) * 256 + wr * 64 + fr; ++cnt;
#pragma unroll
        for (int ai = 0; ai < 2; ++ai)
#pragma unroll
            for (int m = 0; m < 4; ++m) { const int row = row0 + ai * HALF + m * 16; const float sc = tb[ai * HALF + m * 16]; bf16_t* rowp = O + (size_t)row * ldc + col0;
#pragma unroll
                for (int bj = 0; bj < 2; ++bj) { const f32x4 v0 = acc[ai][bj][m][0] * sc, v1 = acc[ai][bj][m][1] * sc;
                    u32x4 w; w.x = cvt_pk_bf16(v0[0], v0[1]); w.y = cvt_pk_bf16(v0[2], v0[3]); w.z = cvt_pk_bf16(v1[0], v1[1]); w.w = cvt_pk_bf16(v1[2], v1[3]);
                    *(u32x4*)(rowp + bj * HALF) = w; } }
    }
};
struct EpiSwiGLU {
    static constexpr bool PERM = true, AFTER_DRAIN = false;
    bf16_t* O; int ldc; mutable int cnt;
    __device__ __forceinline__ void operator()(const f32x4 (&acc)[2][2][4][2], const Unit& u, int wr, int wc, int fr, int fq) const {
        const int row0 = u.pm * BM + wr * 64 + fr, col0 = u.pn * HALF + wc * 32 + 8 * fq; const PG8_LAS float* tb = (const PG8_LAS float*)(unsigned)131072 + (cnt & 1) * 256 + wr * 64 + fr; ++cnt;
#pragma unroll
        for (int ai = 0; ai < 2; ++ai)
#pragma unroll
            for (int m = 0; m < 4; ++m) { const int row = row0 + ai * HALF + m * 16; const float sc = tb[ai * HALF + m * 16];
                float a[8];
#pragma unroll
                for (int n = 0; n < 2; ++n)
#pragma unroll
                    for (int j = 0; j < 4; ++j) { const float g = acc[ai][0][m][n][j] * sc, up = acc[ai][1][m][n][j] * sc; a[4 * n + j] = silu_f(g) * up; }
                u32x4 w; w.x = cvt_pk_bf16(a[0], a[1]); w.y = cvt_pk_bf16(a[2], a[3]); w.z = cvt_pk_bf16(a[4], a[5]); w.w = cvt_pk_bf16(a[6], a[7]);
                *(u32x4*)(O + (size_t)row * ldc + col0) = w; }
    }
};
struct EpiMul {
    static constexpr bool PERM = true, AFTER_DRAIN = false;
    bf16_t* O; int ldc; mutable int cnt;
    __device__ __forceinline__ void operator()(const f32x4 (&acc)[2][2][4][2], const Unit& u, int wr, int wc, int fr, int fq) const {
        const int row0 = u.pm * BM + wr * 64 + fr, col0 = u.pn * HALF + wc * 32 + 8 * fq; const PG8_LAS float* tb = (const PG8_LAS float*)(unsigned)131072 + (cnt & 1) * 256 + wr * 64 + fr; ++cnt;
#pragma unroll
        for (int ai = 0; ai < 2; ++ai)
#pragma unroll
            for (int m = 0; m < 4; ++m) { const int row = row0 + ai * HALF + m * 16; const float sc = tb[ai * HALF + m * 16], sc2 = sc * sc;
                float a[8];
#pragma unroll
                for (int n = 0; n < 2; ++n)
#pragma unroll
                    for (int j = 0; j < 4; ++j) a[4 * n + j] = (acc[ai][0][m][n][j] * acc[ai][1][m][n][j]) * sc2;
                u32x4 w; w.x = cvt_pk_bf16(a[0], a[1]); w.y = cvt_pk_bf16(a[2], a[3]); w.z = cvt_pk_bf16(a[4], a[5]); w.w = cvt_pk_bf16(a[6], a[7]);
                *(u32x4*)(O + (size_t)row * ldc + col0) = w; }
    }
};
template <bool RB>
struct EpiResid {
    static constexpr bool PERM = true, AFTER_DRAIN = false;
    static constexpr int MB = RB ? 4 : 2;
    const float* resid; bf16_t* XB; float* ss_out; int ldc;
    __device__ __forceinline__ void operator()(const f32x4 (&acc)[2][2][4][2], const Unit& u, int wr, int wc, int fr, int fq) const {
        const int row0 = u.pm * BM + wr * 64 + fr, col0 = u.pn * BM + wc * 32 + 8 * fq;
#pragma unroll
        for (int ai = 0; ai < 2; ++ai)
#pragma unroll
          for (int mb = 0; mb < 4; mb += MB) {
            u32x4 rb[MB][2]; f32x4 rf[RB ? 1 : MB][2][2];
#pragma unroll
            for (int mm = 0; mm < MB; ++mm) { const size_t off = (size_t)(row0 + ai * HALF + (mb + mm) * 16) * ldc + col0;
#pragma unroll
                for (int bj = 0; bj < 2; ++bj) {
                    if constexpr (RB) rb[mm][bj] = *(const u32x4*)(XB + off + bj * HALF);
                    else { rf[mm][bj][0] = *(const f32x4*)(resid + off + bj * HALF); rf[mm][bj][1] = *(const f32x4*)(resid + off + bj * HALF + 4); } } }
#pragma unroll
            for (int mm = 0; mm < MB; ++mm) { const int m = mb + mm, row = row0 + ai * HALF + m * 16; const size_t off = (size_t)row * ldc + col0; float s = 0.f;
#pragma unroll
                for (int bj = 0; bj < 2; ++bj) { f32x4 r0, r1;
                    if constexpr (RB) { const u32x4 q = rb[mm][bj];
                        r0[0] = __builtin_bit_cast(float, q.x << 16); r0[1] = __builtin_bit_cast(float, q.x & 0xffff0000u); r0[2] = __builtin_bit_cast(float, q.y << 16); r0[3] = __builtin_bit_cast(float, q.y & 0xffff0000u);
                        r1[0] = __builtin_bit_cast(float, q.z << 16); r1[1] = __builtin_bit_cast(float, q.z & 0xffff0000u); r1[2] = __builtin_bit_cast(float, q.w << 16); r1[3] = __builtin_bit_cast(float, q.w & 0xffff0000u); }
                    else { r0 = rf[mm][bj][0]; r1 = rf[mm][bj][1]; }
                    const f32x4 v0 = acc[ai][bj][m][0] + r0, v1 = acc[ai][bj][m][1] + r1;
                    u32x4 w; w.x = cvt_pk_bf16(v0[0], v0[1]); w.y = cvt_pk_bf16(v0[2], v0[3]); w.z = cvt_pk_bf16(v1[0], v1[1]); w.w = cvt_pk_bf16(v1[2], v1[3]);
                    *(u32x4*)(XB + off + bj * HALF) = w;
                    s += (v0[0] * v0[0] + v0[1] * v0[1]) + (v0[2] * v0[2] + v0[3] * v0[3]) + (v1[0] * v1[0] + v1[1] * v1[1]) + (v1[2] * v1[2] + v1[3] * v1[3]); }
                s += __shfl_xor(s, 16); s += __shfl_xor(s, 32);
                if (fq == 0) ss_out[((size_t)(u.pm * (ldc / BM) + u.pn) * BM + (row - u.pm * BM)) * 4 + wc] = s; }
            asm volatile("" ::: "memory"); }
    }
};

struct RstdOrder : StaticOrder {
    const float* ssp; const float* ss0; int npn; mutable int cnt; mutable int pmA, pmB;
    static __device__ __forceinline__ PG8_LAS float* tbl() { return (PG8_LAS float*)(unsigned)131072; }
    __device__ __forceinline__ void build(const Unit& u) const {
        const int par = cnt & 1; const bool same = cnt >= 2 && (par ? pmB : pmA) == u.pm; if (par) pmB = u.pm; else pmA = u.pm; ++cnt; const int tid = threadIdx.x;
        if (same) return;
        if (tid < 256) { float s;
            if (ssp) { const char* base = (const char*)(ssp + (size_t)(u.pm * npn) * 1024); int to = tid * 16; asm volatile("" : "+v"(to));
                s = 0.f;
#pragma unroll
                for (int pn = 0; pn < 16; ++pn) { const f32x4 v = *(const f32x4*)(base + (size_t)pn * 4096 + (size_t)(unsigned)to); s += (v[0] + v[1]) + (v[2] + v[3]); } }
            else s = ss0[u.pm * BM + tid];
            tbl()[par * 256 + tid] = rstd_of(s); }
    }
    __device__ __forceinline__ void a_ready(const Unit& u) const { if (cnt == 0) build(u); }
    __device__ __forceinline__ void after_epi(const Unit& u) const { build(u); }
};

template <class Epi, class Sched, bool ALIGN_EPI = false, bool SP2 = false>
__device__ __forceinline__ void gemm_phase(PG8_LAS unsigned char* lds, const Gemm g, const Sched& S, const Epi& E) {
    const int tid = threadIdx.x, wid = __builtin_amdgcn_readfirstlane(tid >> 6), lane = tid & 63, wr = wid >> 2, wc = wid & 3, fr = lane & 15, fq = lane >> 4;
    const int K = g.K, nt = K / BK;
    unsigned voffA[2], voffB[2];
#pragma unroll
    for (int i = 0; i < 2; ++i) { int R, C; stage_rc(tid * 16 + i * 8192, R, C); const int Rb = Epi::PERM ? ((R & ~31) + perm32(R & 31)) : R;
        voffA[i] = (unsigned)(R * K + C) * 2u; voffB[i] = (unsigned)(Rb * K + C) * 2u; }
    const size_t kstep = (size_t)(BK * 2);
    const size_t hstep = (size_t)HALF * K * 2;
    const size_t tstep = 2 * hstep;
    const unsigned ldsw = (unsigned)wid * 1024u;
    const int aoff = lds_byte(wr * 64 + fr, fq * 8), boff = lds_byte(wc * 32 + fr, fq * 8);
#define PG8_SA(b, h) (((b) * 2 + (h)) * HTB)
#define PG8_SB(b, h) ((4 + (b) * 2 + (h)) * HTB)
#define PG8_STAGE(bufoff, gbase, voff) do { _Pragma("unroll") for (int _i = 0; _i < 2; ++_i) \
        __builtin_amdgcn_global_load_lds((const unsigned*)((const char*)(gbase) + (voff)[_i]), (PG8_LAS unsigned*)(lds + (bufoff) + ldsw + _i * 8192), 16, 0, 0); } while (0)
#define PG8_LDA(dst, b, h) do { _Pragma("unroll") for (int m = 0; m < 4; ++m) _Pragma("unroll") for (int k = 0; k < 2; ++k) dst[m][k] = *(const PG8_LAS bf16x8*)(lds + PG8_SA(b, h) + aoff + m * 2048 + k * 1024); } while (0)
#define PG8_LDB(dst, b, h) do { _Pragma("unroll") for (int n = 0; n < 2; ++n) _Pragma("unroll") for (int k = 0; k < 2; ++k) dst[n][k] = *(const PG8_LAS bf16x8*)(lds + PG8_SB(b, h) + boff + n * 2048 + k * 1024); } while (0)
#define PG8_MMA(ai, bj, At, Bt) do { __builtin_amdgcn_s_setprio(1); _Pragma("unroll") for (int m = 0; m < 4; ++m) _Pragma("unroll") for (int n = 0; n < 2; ++n) _Pragma("unroll") for (int k = 0; k < 2; ++k) \
        acc[ai][bj][m][n] = __builtin_amdgcn_mfma_f32_16x16x32_bf16(Bt[n][k], At[m][k], acc[ai][bj][m][n], 0, 0, 0); __builtin_amdgcn_s_setprio(0); } while (0)
#define PG8_WAIT_V(n) asm volatile("s_waitcnt vmcnt(" #n ")" ::: "memory")
#define PG8_WAIT_L(n) asm volatile("s_waitcnt lgkmcnt(" #n ")" ::: "memory")
#define PG8_BAR __builtin_amdgcn_s_barrier()
#define PG8_SCHED __builtin_amdgcn_sched_barrier(0)
    Unit cur, nxt; int ui = 0;
    if (!S.next(0, cur)) return;
    f32x4 acc[2][2][4][2];
#pragma unroll
    for (int a = 0; a < 2; ++a)
#pragma unroll
        for (int b = 0; b < 2; ++b)
#pragma unroll
            for (int m = 0; m < 4; ++m)
#pragma unroll
                for (int n = 0; n < 2; ++n) acc[a][b][m][n] = (f32x4){0.f, 0.f, 0.f, 0.f};
    bf16x8 At[4][2], B0[2][2], B1[2][2];
    const char* cA = (const char*)g.A + (size_t)cur.pm * tstep; const char* cB = (const char*)g.Bt + (size_t)cur.pn * tstep;
    S.a_ready(cur);
    if constexpr (SP2) {
        PG8_STAGE(PG8_SB(0, 0), cB, voffB); PG8_STAGE(PG8_SB(0, 1), cB + hstep, voffB); PG8_STAGE(PG8_SA(0, 0), cA, voffA); PG8_STAGE(PG8_SA(0, 1), cA + hstep, voffA);
        if (wr == 1) PG8_BAR;
        PG8_WAIT_V(2); PG8_BAR;
        PG8_STAGE(PG8_SB(1, 0), cB + kstep, voffB); PG8_STAGE(PG8_SA(1, 0), cA + kstep, voffA); PG8_STAGE(PG8_SB(1, 1), cB + hstep + kstep, voffB);
        PG8_WAIT_V(6); PG8_BAR;
    } else {
        PG8_STAGE(PG8_SB(0, 0), cB, voffB); PG8_STAGE(PG8_SA(0, 0), cA, voffA); PG8_STAGE(PG8_SB(0, 1), cB + hstep, voffB); PG8_STAGE(PG8_SA(0, 1), cA + hstep, voffA);
        if (wr == 1) PG8_BAR;
        PG8_WAIT_V(4); PG8_BAR;
        PG8_STAGE(PG8_SB(1, 0), cB + kstep, voffB); PG8_STAGE(PG8_SA(1, 0), cA + kstep, voffA); PG8_STAGE(PG8_SB(1, 1), cB + hstep + kstep, voffB);
        PG8_WAIT_V(6); PG8_BAR;
    }
    for (;;) {
        const bool has_next = S.next(ui + 1, nxt);
        const char* nA = has_next ? (const char*)g.A + (size_t)nxt.pm * tstep : cA; const char* nB = has_next ? (const char*)g.Bt + (size_t)nxt.pn * tstep : cB;
        for (int t = 0; t < nt; t += 2) {
            const bool last = (t == nt - 2);
            const char* a1 = cA + (size_t)(t + 1) * kstep;
            const char* a2 = last ? nA : cA + (size_t)(t + 2) * kstep; const char* b2 = last ? nB : cB + (size_t)(t + 2) * kstep;
            const char* a3 = a2 + kstep; const char* b3 = b2 + kstep;
            if (last && has_next) S.a_ready(nxt);
            if constexpr (SP2) {
            PG8_LDB(B0, 0, 0); PG8_LDB(B1, 0, 1); PG8_SCHED; PG8_LDA(At, 0, 0); PG8_STAGE(PG8_SA(1, 1), a1 + hstep, voffA);
            PG8_WAIT_V(8); PG8_WAIT_L(0); PG8_BAR; PG8_MMA(0, 0, At, B0); PG8_MMA(0, 1, At, B1); PG8_BAR; PG8_SCHED;
            PG8_LDA(At, 0, 1); PG8_STAGE(PG8_SB(0, 0), b2, voffB); PG8_STAGE(PG8_SB(0, 1), b2 + hstep, voffB); PG8_STAGE(PG8_SA(0, 0), a2, voffA);
            PG8_WAIT_V(8); PG8_WAIT_L(0); PG8_BAR; PG8_MMA(1, 0, At, B0); PG8_MMA(1, 1, At, B1); PG8_BAR; PG8_SCHED;
            PG8_LDB(B0, 1, 0); PG8_LDB(B1, 1, 1); PG8_SCHED; PG8_LDA(At, 1, 0); PG8_STAGE(PG8_SA(0, 1), a2 + hstep, voffA);
            PG8_WAIT_V(8); PG8_WAIT_L(0); PG8_BAR; PG8_MMA(0, 0, At, B0); PG8_MMA(0, 1, At, B1); PG8_BAR; PG8_SCHED;
            PG8_LDA(At, 1, 1); PG8_STAGE(PG8_SB(1, 0), b3, voffB); PG8_STAGE(PG8_SB(1, 1), b3 + hstep, voffB); PG8_STAGE(PG8_SA(1, 0), a3, voffA);
            PG8_WAIT_V(8); PG8_WAIT_L(0); PG8_BAR; PG8_MMA(1, 0, At, B0); PG8_MMA(1, 1, At, B1); PG8_BAR; PG8_SCHED;
            } else {
            PG8_LDB(B0, 0, 0); PG8_SCHED; PG8_LDA(At, 0, 0); PG8_STAGE(PG8_SA(1, 1), a1 + hstep, voffA);
            PG8_WAIT_L(8); PG8_BAR; PG8_WAIT_L(0); PG8_MMA(0, 0, At, B0); PG8_BAR; PG8_SCHED;
            PG8_LDB(B1, 0, 1); PG8_STAGE(PG8_SB(0, 0), b2, voffB);
            PG8_BAR; PG8_WAIT_L(0); PG8_MMA(0, 1, At, B1); PG8_BAR;
            PG8_LDA(At, 0, 1); PG8_STAGE(PG8_SA(0, 0), a2, voffA);
            PG8_BAR; PG8_WAIT_L(0); PG8_MMA(1, 0, At, B0); PG8_BAR; PG8_SCHED;
            PG8_STAGE(PG8_SB(0, 1), b2 + hstep, voffB);
            PG8_WAIT_V(6); PG8_BAR; PG8_MMA(1, 1, At, B1); PG8_BAR;
            PG8_LDB(B0, 1, 0); PG8_SCHED; PG8_LDA(At, 1, 0); PG8_STAGE(PG8_SA(0, 1), a2 + hstep, voffA);
            PG8_WAIT_L(8); PG8_BAR; PG8_WAIT_L(0); PG8_MMA(0, 0, At, B0); PG8_BAR; PG8_SCHED;
            PG8_LDB(B1, 1, 1); PG8_STAGE(PG8_SB(1, 0), b3, voffB);
            PG8_BAR; PG8_WAIT_L(0); PG8_MMA(0, 1, At, B1); PG8_BAR;
            PG8_LDA(At, 1, 1); PG8_STAGE(PG8_SA(1, 0), a3, voffA);
            PG8_BAR; PG8_WAIT_L(0); PG8_MMA(1, 0, At, B0); PG8_BAR; PG8_SCHED;
            PG8_STAGE(PG8_SB(1, 1), b3 + hstep, voffB);
            PG8_WAIT_V(6); PG8_BAR; PG8_MMA(1, 1, At, B1); PG8_BAR;
            }
        }
        if constexpr (ALIGN_EPI) { if (wr == 0) PG8_BAR; }
        if constexpr (!Epi::AFTER_DRAIN) { E(acc, cur, wr, wc, fr, fq); S.done(cur); __builtin_amdgcn_sched_barrier(0); if (has_next) S.after_epi(nxt); __builtin_amdgcn_sched_barrier(0); }
        if (!has_next) break;
#pragma unroll
        for (int a = 0; a < 2; ++a)
#pragma unroll
            for (int b = 0; b < 2; ++b)
#pragma unroll
                for (int m = 0; m < 4; ++m)
#pragma unroll
                    for (int n = 0; n < 2; ++n) acc[a][b][m][n] = (f32x4){0.f, 0.f, 0.f, 0.f};
        cur = nxt; cA = nA; cB = nB; ++ui;
        if constexpr (ALIGN_EPI) { if (wr == 1) PG8_BAR; }
    }
    PG8_WAIT_V(0);
    if constexpr (!ALIGN_EPI) { if (wr == 0) PG8_BAR; }
    PG8_BAR;
    if constexpr (Epi::AFTER_DRAIN) { E.fused(acc, cur, wr, wc, fr, fq, lds, wid, lane); S.done(cur); }
#undef PG8_SA
#undef PG8_SB
#undef PG8_STAGE
#undef PG8_LDA
#undef PG8_LDB
#undef PG8_MMA
#undef PG8_WAIT_V
#undef PG8_WAIT_L
#undef PG8_BAR
#undef PG8_SCHED
}
}

constexpr int NWAVES = 8;
constexpr int D = 4096, NB = 4, SEQ = 4096, M = NB * SEQ, NMETA = 16, LTOK = SEQ + NMETA;
constexpr int GH = 4, DK = 512, DV = 1024, QK = 2048, GV = 4096, GR = 16, GIN = 12304, NQKVR = 12288, MGIN = 12320  ;
constexpr int FF = 11008, NGU = 2 * FF;
constexpr float EPS = 1e-6f;
#define DIAG_POISON 0
#define GS_NO_DMA 0
#define GS_C_PACK 0
#ifndef MK_CUTS
#define MK_CUTS 0u
#endif
constexpr int N_PHASES = 14;

constexpr size_t MiB = 1u << 20;
constexpr size_t WS_CTL = 0, CTL_ZERO_BYTES = 2 * MiB;
constexpr size_t WS_WGIN = 2 * MiB;
constexpr size_t WS_WGOUT = 99 * MiB;
constexpr size_t WS_WGU0 = 131 * MiB;
constexpr size_t WS_WDN0 = 303 * MiB;
constexpr size_t WS_WCIN = 389 * MiB;
constexpr size_t WS_WCOUT = 485 * MiB;
constexpr size_t WS_WGU1 = 517 * MiB;
constexpr size_t WS_WDN1 = 689 * MiB;
constexpr size_t WS_XB = 775 * MiB;
constexpr size_t WS_OG = 903 * MiB;
constexpr size_t WS_PROJ = 1031 * MiB;
constexpr size_t WS_O = 1415 * MiB;
constexpr size_t WS_QDF = 1543 * MiB;
constexpr size_t WS_KDNTF = 1607 * MiB;
constexpr size_t WS_ALOW = 1671 * MiB;
constexpr size_t WS_META = 1672 * MiB;
constexpr size_t WS_SC = 1676 * MiB;
constexpr size_t WS_EBL = 1684 * MiB;
constexpr size_t WS_SSP = 1686 * MiB;
constexpr size_t WS_END = 1690 * MiB;
constexpr size_t MT_XB = 0, MT_PROJ = 128 * 1024, MT_O = MT_PROJ + 800 * 1024, MT_OG = MT_O + 256 * 1024, MT_H = MT_OG + 128 * 1024, MT_ACT = MT_H + 256 * 1024, MT_Z = MT_ACT + 352 * 1024,
                 MT_QDF = 2048 * 1024, MT_KDNTF = MT_QDF + 256 * 1024, MT_SC = MT_KDNTF + 256 * 1024, MT_EBL = MT_SC + 32 * 1024;
static_assert(MT_PROJ + (size_t)16 * MGIN * 4 <= MT_O && MT_Z + 2 * 4096 * 4 <= MT_QDF && MT_EBL + 8 * 1024 <= 4 * MiB, "meta map");
constexpr int CW_BAR = 4096;
constexpr int CW_SS = 262144;
constexpr int CW_MSS = CW_SS + 5 * M;
constexpr int MSS_STRIDE = 64;
static_assert((size_t)(CW_MSS + 5 * MSS_STRIDE) * 4 <= CTL_ZERO_BYTES && CW_BAR + N_PHASES * 3456 <= CW_SS, "ctl map");

constexpr int RING_OFF = 0, RING_BYTES = 131072;
constexpr int LDS_BYTES = 163840, LDSCTL_OFF = LDS_BYTES - 1024, MISC_OFF = LDSCTL_OFF + 320;

#define GAS __attribute__((address_space(1)))
#define LAS __attribute__((address_space(3)))
typedef unsigned short bf16;
typedef unsigned v4u __attribute__((ext_vector_type(4)));
typedef unsigned v2u __attribute__((ext_vector_type(2)));
typedef float f32x4 __attribute__((ext_vector_type(4)));
typedef short bf16x8 __attribute__((ext_vector_type(8)));
#define LDS_WAIT() asm volatile("s_waitcnt lgkmcnt(0)" ::: "memory")
#define VM_WAIT() asm volatile("s_waitcnt vmcnt(0)" ::: "memory")
__device__ __forceinline__ unsigned f2bf(float f) { unsigned u = __builtin_bit_cast(unsigned, f); return (u + 0x7fffu + ((u >> 16) & 1u)) >> 16; }
__device__ __forceinline__ unsigned pk2(float lo, float hi) { return f2bf(lo) | (f2bf(hi) << 16); }
__device__ __forceinline__ float bf2f(unsigned short b) { return __builtin_bit_cast(float, (unsigned)b << 16); }
__device__ __forceinline__ float bflo(unsigned w) { return __builtin_bit_cast(float, w << 16); }
__device__ __forceinline__ float bfhi(unsigned w) { return __builtin_bit_cast(float, w & 0xffff0000u); }
__device__ __forceinline__ float wave_sum(float v) {
#pragma unroll
    for (int o = 1; o < 64; o <<= 1) v += __shfl_xor(v, o);
    return v;
}
using pg8::rstd_of; using pg8::silu_f;

#define XB_TMO      128
#define XB_XCNT(j)  (256  + 64 * (j))
#define XB_XSUB(j)  (1280 + 64 * (j))
#define XB_XGEN(j)  (2304 + 64 * (j))
#define XB_TOP      3328
#define XB_TOPGEN   3392
#define XCD_BAR_WORDS 3456
#define XB_SPIN_CAP (1u << 18)

__device__ __forceinline__ unsigned xb_ld(unsigned* p)              { return __hip_atomic_load(p, __ATOMIC_RELAXED, __HIP_MEMORY_SCOPE_AGENT); }
__device__ __forceinline__ unsigned xb_add(unsigned* p, unsigned v) { return __hip_atomic_fetch_add(p, v, __ATOMIC_RELAXED, __HIP_MEMORY_SCOPE_AGENT); }
__device__ __forceinline__ unsigned xb_xcc_id() { return (unsigned)__builtin_amdgcn_s_getreg((3 << 11) | 20) & 0xFu; }
#define XB_SPIN(cond, bar) do { unsigned _sp = 0; while (cond) { __builtin_amdgcn_s_sleep(1); \
    if ((++_sp & 255u) == 0u) { if (xb_ld(&(bar)[XB_TMO])) break; if (_sp > XB_SPIN_CAP) { atomicAdd(&(bar)[XB_TMO], 1u); break; } } } } while (0)

struct XcdBarrier {
    unsigned* bar; unsigned x;
    volatile LAS unsigned* st;
};

__device__ __forceinline__ XcdBarrier xcd_barrier_post(unsigned* bar, volatile LAS unsigned* st) {
    XcdBarrier b; b.bar = bar; b.x = xb_xcc_id(); b.st = st;
    if (threadIdx.x == 0) (void)xb_add(&bar[XB_XCNT(b.x)], 1u);
    return b;
}
__device__ __forceinline__ void xcd_barrier_complete(unsigned* bar, unsigned x, unsigned& nloc, unsigned& nx) {
    const unsigned G = gridDim.x * gridDim.y * gridDim.z;
    unsigned sum, cnt, mine, sp = 0u;
    for (;;) {
        sum = 0u; cnt = 0u; mine = 0u;
#pragma unroll
        for (unsigned j = 0; j < 16; ++j) { const unsigned c = xb_ld(&bar[XB_XCNT(j)]); sum += c; cnt += (c > 0u) ? 1u : 0u; mine = (j == x) ? c : mine; }
        if (sum == G) break;
        __builtin_amdgcn_s_sleep(1);
        if ((++sp & 255u) == 0u) { if (xb_ld(&bar[XB_TMO])) break; if (sp > XB_SPIN_CAP) { atomicAdd(&bar[XB_TMO], 1u); break; } }
    }
    nloc = mine > 0u ? mine : 1u; nx = cnt > 0u ? cnt : 1u;
}

__device__ __forceinline__ void xcd_barrier(const XcdBarrier& b) {
    asm volatile("s_waitcnt vmcnt(0)" ::: "memory");
    __syncthreads();
    if (threadIdx.x == 0) {
        unsigned* bar = b.bar;
        __builtin_amdgcn_s_waitcnt(0);
        unsigned nloc = b.st[0], nx = b.st[1];
        if (nloc == 0u) { xcd_barrier_complete(bar, b.x, nloc, nx); b.st[0] = nloc; b.st[1] = nx; }
        const unsigned old = xb_add(&bar[XB_XSUB(b.x)], 1u);
        const unsigned gen = old / nloc;
        if (old + 1u == (gen + 1u) * nloc) {
            __builtin_amdgcn_fence(__ATOMIC_RELEASE, "agent");
            asm volatile("s_waitcnt vmcnt(0)" ::: "memory");
            const unsigned og = xb_add(&bar[XB_TOP], 1u);
            const unsigned tg = og / nx;
            if (og + 1u == (tg + 1u) * nx) xb_add(&bar[XB_TOPGEN], 1u);
            else XB_SPIN(xb_ld(&bar[XB_TOPGEN]) == tg, bar);
            __builtin_amdgcn_fence(__ATOMIC_ACQUIRE, "agent");
            xb_add(&bar[XB_XGEN(b.x)], 1u);
            asm volatile("s_waitcnt vmcnt(0)" ::: "memory");
        } else {
            XB_SPIN(xb_ld(&bar[XB_XGEN(b.x)]) == gen, bar);
            __builtin_amdgcn_fence(__ATOMIC_ACQUIRE, "agent");
            asm volatile("s_waitcnt vmcnt(0)" ::: "memory");
        }
    }
    __syncthreads();
}

template <int MODE>
__device__ __forceinline__ void cvt_task(const float* __restrict__ W, int K, int ldw, int ncols, const float* __restrict__ gk, bf16* __restrict__ WT, LAS float* scr, int gw, int ngw, int lane) {
    const int nblk = (ncols + 31) / 32, nitems = (K / 64) * nblk, n = lane & 31, hi = lane >> 5, c = lane & 7;
    float v[32];
#define CVT_LOAD(it_) do { const int kb_ = (it_) / nblk, n0_ = ((it_) % nblk) * 32; const bool ok_ = n0_ + n < ncols; const float* wp_ = W + (size_t)(kb_ * 64 + hi) * ldw + n0_ + n; \
        _Pragma("unroll") for (int i = 0; i < 32; ++i) v[i] = ok_ ? wp_[(size_t)(2 * i) * ldw] : 0.f; } while (0)
    int it = gw;
    if (it < nitems) CVT_LOAD(it);
    while (it < nitems) {
        const int kb = it / nblk, n0 = (it % nblk) * 32, k0 = kb * 64; const int ncv = (ncols - n0) < 32 ? (ncols - n0) : 32;
        long dr = n0; if (MODE == 1) dr = (long)(n0 / 128) * 256 + (n0 % 128); if (MODE == 2) dr = (long)(n0 / 128) * 256 + 128 + (n0 % 128);
#pragma unroll
        for (int i = 0; i < 32; ++i) scr[(2 * i + hi) * 33 + n] = v[i];
        f32x4 ga = {1.f, 1.f, 1.f, 1.f}, gb = {1.f, 1.f, 1.f, 1.f};
        if (gk) { ga = *(const f32x4*)(gk + k0 + 8 * c); gb = *(const f32x4*)(gk + k0 + 8 * c + 4); }
        const int nxt = it + ngw;
        if (nxt < nitems) CVT_LOAD(nxt);
        LDS_WAIT(); asm volatile("" ::: "memory");
#pragma unroll
        for (int j = 0; j < 4; ++j) { const int nn = (lane >> 3) + 8 * j; const LAS float* s = scr + (8 * c) * 33 + nn;
            v4u o; o.x = pk2(s[0 * 33] * ga.x, s[1 * 33] * ga.y); o.y = pk2(s[2 * 33] * ga.z, s[3 * 33] * ga.w); o.z = pk2(s[4 * 33] * gb.x, s[5 * 33] * gb.y); o.w = pk2(s[6 * 33] * gb.z, s[7 * 33] * gb.w);
            if (nn < ncv) *(v4u*)(WT + (size_t)(dr + nn) * K + k0 + 8 * c) = o; }
        LDS_WAIT(); asm volatile("" ::: "memory");
        it = nxt;
    }
#undef CVT_LOAD
}
__device__ __forceinline__ void row_to_bf16_ss(const float* xrow, bf16* orow, float* ss, int lane) {
    const f32x4* xr = (const f32x4*)xrow + lane; f32x4 v[16]; float s = 0.f;
#pragma unroll
    for (int j = 0; j < 16; ++j) { v[j] = xr[64 * j]; s += (v[j].x * v[j].x + v[j].y * v[j].y) + (v[j].z * v[j].z + v[j].w * v[j].w); }
    s = wave_sum(s); if (lane == 0) *ss = s;
    v2u* o8 = (v2u*)orow + lane;
#pragma unroll
    for (int j = 0; j < 16; ++j) { v2u w; w.x = pk2(v[j].x, v[j].y); w.y = pk2(v[j].z, v[j].w); o8[64 * j] = w; }
}

template <bool PAIR, class Epi>
__device__ __forceinline__ void thin_gemm16(LAS unsigned char* lds, const bf16* __restrict__ A16, const bf16* __restrict__ Bt, int K, int ntiles, long pair_off, const Epi& epi, int wg, int nwg) {
    const int tid = threadIdx.x, wave = __builtin_amdgcn_readfirstlane(tid >> 6), lane = tid & 63, i = lane & 15, q = lane >> 4;
    LAS float* red = (LAS float*)lds;
    const int nblk = K / 128, kb0 = wave * nblk / 8, kb1 = (wave + 1) * nblk / 8;
    for (int t4 = wg * 4; t4 < ntiles; t4 += nwg * 4)
    for (int t = t4; t < t4 + 4 && t < ntiles; ++t) {
        const long n0 = epi.row0(t);
        const bf16* ap = A16 + (size_t)i * K + 32 * q;
        const bf16* bp = Bt + (size_t)(n0 + i) * K + 32 * q;
        const bf16* bp2 = bp + (size_t)pair_off * K;
        f32x4 acc0 = {0.f, 0.f, 0.f, 0.f}, acc1 = {0.f, 0.f, 0.f, 0.f};
#pragma unroll 2
        for (int kb = kb0; kb < kb1; ++kb) {
            const bf16x8* a = (const bf16x8*)(ap + kb * 128); const bf16x8* b = (const bf16x8*)(bp + kb * 128);
            const bf16x8 a0 = a[0], a1 = a[1], a2 = a[2], a3 = a[3], b0 = b[0], b1 = b[1], b2 = b[2], b3 = b[3];
            acc0 = __builtin_amdgcn_mfma_f32_16x16x32_bf16(a0, b0, acc0, 0, 0, 0); acc0 = __builtin_amdgcn_mfma_f32_16x16x32_bf16(a1, b1, acc0, 0, 0, 0);
            acc0 = __builtin_amdgcn_mfma_f32_16x16x32_bf16(a2, b2, acc0, 0, 0, 0); acc0 = __builtin_amdgcn_mfma_f32_16x16x32_bf16(a3, b3, acc0, 0, 0, 0);
            if (PAIR) { const bf16x8* c = (const bf16x8*)(bp2 + kb * 128); const bf16x8 c0 = c[0], c1 = c[1], c2 = c[2], c3 = c[3];
                acc1 = __builtin_amdgcn_mfma_f32_16x16x32_bf16(a0, c0, acc1, 0, 0, 0); acc1 = __builtin_amdgcn_mfma_f32_16x16x32_bf16(a1, c1, acc1, 0, 0, 0);
                acc1 = __builtin_amdgcn_mfma_f32_16x16x32_bf16(a2, c2, acc1, 0, 0, 0); acc1 = __builtin_amdgcn_mfma_f32_16x16x32_bf16(a3, c3, acc1, 0, 0, 0); }
        }
#pragma unroll
        for (int j = 0; j < 4; ++j) { red[((wave * 2 + 0) * 4 + j) * 64 + lane] = acc0[j]; if (PAIR) red[((wave * 2 + 1) * 4 + j) * 64 + lane] = acc1[j]; }
        __syncthreads();
        if (tid < 256) { const int l = tid & 63, j = tid >> 6; float v0 = 0.f, v1 = 0.f;
#pragma unroll
            for (int w = 0; w < 8; ++w) { v0 += red[((w * 2 + 0) * 4 + j) * 64 + l]; if (PAIR) v1 += red[((w * 2 + 1) * 4 + j) * 64 + l]; }
            epi(t, 4 * (l >> 4) + j, l & 15, v0, v1); }
        __syncthreads();
    }
}


__device__ __forceinline__ void thin_row_rstd(LAS float* tbl, const float* __restrict__ X) {
    const int tid = threadIdx.x, r = tid >> 5, l = tid & 31; const f32x4* xr = (const f32x4*)(X + (size_t)r * D) + l; float s = 0.f;
#pragma unroll 8
    for (int j = 0; j < 32; ++j) { const f32x4 v = xr[32 * j]; s += (v.x * v.x + v.y * v.y) + (v.z * v.z + v.w * v.w); }
    s += __shfl_xor(s, 1); s += __shfl_xor(s, 2); s += __shfl_xor(s, 4); s += __shfl_xor(s, 8); s += __shfl_xor(s, 16);
    if (l == 0) tbl[r] = rstd_of(s);
    __syncthreads();
}

struct TE_ALow {
    float* alow; const float* ss;
    __device__ __forceinline__ long row0(int t) const { return (long)t * 16; }
    __device__ __forceinline__ void operator()(int t, int r, int c, float v0, float) const { const int tok = t * 16 + c; alow[(size_t)tok * 16 + r] = v0 * rstd_of(ss[tok]); }
};
struct TE_MProj {
    float* mproj; const LAS float* rs;
    __device__ __forceinline__ long row0(int t) const { return (long)t * 16; }
    __device__ __forceinline__ void operator()(int t, int r, int c, float v0, float) const { mproj[(size_t)r * MGIN + t * 16 + c] = v0 * rs[r]; }
};
struct TE_MResid {
    const float* resid; float* mh; bf16* mxb; float* mss_out;
    __device__ __forceinline__ long row0(int t) const { return (long)t * 16; }
    __device__ __forceinline__ void operator()(int t, int r, int c, float v0, float) const {
        const size_t o = (size_t)r * D + t * 16 + c; const float h = resid[o] + v0; mh[o] = h; mxb[o] = (bf16)f2bf(h);
        (void)mss_out;
    }
};
struct TE_MSwiGLU {
    bf16* mact; const LAS float* rs;
    __device__ __forceinline__ long row0(int t) const { return (long)(t >> 3) * 256 + (t & 7) * 16; }
    __device__ __forceinline__ void operator()(int t, int r, int c, float v0, float v1) const { const float sc = rs[r];
        mact[(size_t)r * FF + (t >> 3) * 128 + (t & 7) * 16 + c] = (bf16)f2bf(silu_f(v0 * sc) * (v1 * sc)); }
};
struct TE_MConvZ {
    float* zm; const LAS float* rs;
    __device__ __forceinline__ long row0(int t) const { return 4096 + (long)(t >> 3) * 256 + (t & 7) * 16; }
    __device__ __forceinline__ void operator()(int t, int r, int c, float v0, float v1) const { const float sc = rs[r];
        if (r >= 14) zm[(size_t)(r - 14) * D + t * 16 + c] = (v0 * sc) * (v1 * sc); }
};

typedef float f32x16 __attribute__((ext_vector_type(16)));
#define MFMA32(a, b, c) __builtin_amdgcn_mfma_f32_32x32x16_bf16((a), (b), (c), 0, 0, 0)
constexpr int GP_LD = 1040;
constexpr int GP_QD = 0, GP_KDN = 64 * GP_LD, GP_AL = 2 * 64 * GP_LD;
constexpr int GS_KT = 0, GS_OP = 65536, GS_VT = 131072, GS_VT_LD = 144, GS_EB = GS_VT + 64 * GS_VT_LD;
constexpr int GLA_ITEM_FR = 64 * 512;
__device__ __forceinline__ bf16x8 pack_step(const f32x16& x, int s) {
    v4u p;
#if GS_C_PACK
    if (s == 0) { p[0] = pk2(x[0], x[1]); p[1] = pk2(x[2], x[3]); p[2] = pk2(x[4], x[5]); p[3] = pk2(x[6], x[7]); }
    else { p[0] = pk2(x[8], x[9]); p[1] = pk2(x[10], x[11]); p[2] = pk2(x[12], x[13]); p[3] = pk2(x[14], x[15]); }
    return __builtin_bit_cast(bf16x8, p);
#endif
    if (s == 0) asm volatile("v_cvt_pk_bf16_f32 %0, %4, %5\n\tv_cvt_pk_bf16_f32 %1, %6, %7\n\tv_cvt_pk_bf16_f32 %2, %8, %9\n\tv_cvt_pk_bf16_f32 %3, %10, %11\n\ts_nop 1"
               : "=&v"(p[0]), "=&v"(p[1]), "=&v"(p[2]), "=&v"(p[3]) : "v"(x[0]), "v"(x[1]), "v"(x[2]), "v"(x[3]), "v"(x[4]), "v"(x[5]), "v"(x[6]), "v"(x[7]));
    else asm volatile("v_cvt_pk_bf16_f32 %0, %4, %5\n\tv_cvt_pk_bf16_f32 %1, %6, %7\n\tv_cvt_pk_bf16_f32 %2, %8, %9\n\tv_cvt_pk_bf16_f32 %3, %10, %11\n\ts_nop 1"
               : "=&v"(p[0]), "=&v"(p[1]), "=&v"(p[2]), "=&v"(p[3]) : "v"(x[8]), "v"(x[9]), "v"(x[10]), "v"(x[11]), "v"(x[12]), "v"(x[13]), "v"(x[14]), "v"(x[15]));
    return __builtin_bit_cast(bf16x8, p);
}
__device__ __forceinline__ void gla_prep_item(LAS unsigned char* sm, bool meta, const bf16* __restrict__ prow  , const float* __restrict__ arow  ,
                                              const float* __restrict__ MPROJ, int h, const float* __restrict__ w_a2, const float* __restrict__ b_a,
                                              bf16* __restrict__ qdf, bf16* __restrict__ kdntf, bf16* __restrict__ sc, float* __restrict__ ebl) {
    const int tid = threadIdx.x, wave = __builtin_amdgcn_readfirstlane(tid >> 6), lane = tid & 63, k = tid, kcol = h * DK + k;
    LAS float* AL = (LAS float*)(sm + GP_AL);
    if (tid < 256) { f32x4 a4 = {0.f, 0.f, 0.f, 0.f};
        if (!meta) a4 = *((const f32x4*)arow + tid);
        else { const int t = tid >> 2; if (t >= 48) a4 = *((const f32x4*)(MPROJ + (size_t)(t - 48) * MGIN + NQKVR) + (tid & 3)); }
        *((LAS f32x4*)AL + tid) = a4; }
    float w[16];
#pragma unroll
    for (int r = 0; r < 16; ++r) w[r] = w_a2[r * QK + kcol];
    const float ba = b_a[kcol];
    __syncthreads();
    float bc = 0.f;
    for (int g8 = 0; g8 < 8; ++g8) {
        float qv[8], kv[8];
#pragma unroll
        for (int e = 0; e < 8; ++e) { const int t = g8 * 8 + e;
            if (!meta) { qv[e] = bf2f(prow[(size_t)t * NQKVR + kcol]); kv[e] = bf2f(prow[(size_t)t * NQKVR + QK + kcol]); }
            else if (t >= 48) { qv[e] = MPROJ[(size_t)(t - 48) * MGIN + kcol]; kv[e] = MPROJ[(size_t)(t - 48) * MGIN + QK + kcol]; }
            else { qv[e] = 0.f; kv[e] = 0.f; } }
        unsigned kp[4];
#pragma unroll
        for (int e = 0; e < 8; ++e) { const int t = g8 * 8 + e;
            if (!meta || t >= 48) {
                float x = ba;
#pragma unroll
                for (int r4 = 0; r4 < 4; ++r4) { const f32x4 a4 = *((const LAS f32x4*)AL + t * 4 + r4); x += a4.x * w[4 * r4] + a4.y * w[4 * r4 + 1] + a4.z * w[4 * r4 + 2] + a4.w * w[4 * r4 + 3]; }
                const float ls = fminf(x, 0.f) - __logf(1.0f + __expf(-fabsf(x)));
                bc += ls * (1.0f / 16.0f); }
            const float eb = __expf(bc), en = 1.0f / eb;
            const unsigned qd = f2bf(qv[e] * eb * 0.04419417382415922f), kd = f2bf(kv[e] * en);
            *(LAS unsigned short*)(sm + GP_QD + t * GP_LD + k * 2) = (unsigned short)qd;
            *(LAS unsigned short*)(sm + GP_KDN + t * GP_LD + k * 2) = (unsigned short)kd;
            if (e & 1) kp[e >> 1] |= kd << 16; else kp[e >> 1] = kd; }
        { v4u o; o.x = kp[0]; o.y = kp[1]; o.z = kp[2]; o.w = kp[3];
          *(v4u*)(kdntf + ((size_t)(((k >> 5) * 4 + (g8 >> 1)) * 64 + (k & 31) + 32 * (g8 & 1))) * 8) = o; }
    }
    ebl[k] = __expf(bc);
    __syncthreads();
    const int r = lane & 31, hh = lane >> 5;
    if (wave < 4) {
        const int ti = wave & 1, tj = wave >> 1;
        f32x16 acc;
#pragma unroll
        for (int i = 0; i < 16; ++i) acc[i] = 0.f;
        const LAS unsigned char* pa = sm + GP_QD + (32 * ti + r) * GP_LD + 16 * hh; const LAS unsigned char* pb = sm + GP_KDN + (32 * tj + r) * GP_LD + 16 * hh;
#pragma unroll 8
        for (int kb = 0; kb < 32; ++kb) { const bf16x8 a = *(const LAS bf16x8*)(pa + kb * 32), b = *(const LAS bf16x8*)(pb + kb * 32); acc = MFMA32(a, b, acc); }
#pragma unroll
        for (int i = 0; i < 16; ++i) { const int ii = 32 * ti + (i & 3) + 8 * (i >> 2) + 4 * hh, jj = 32 * tj + r; sc[ii * 64 + jj] = (bf16)f2bf(jj <= ii ? acc[i] : 0.f); }
    } else {
        const int t2 = tid - 256;
#pragma unroll 4
        for (int n = 0; n < 16; ++n) { const int pi = t2 + 256 * n, f = pi >> 6, l = pi & 63, rr = l & 31, h2 = l >> 5, kt = f >> 2, s = (f >> 1) & 1, tt = f & 1;
            const LAS unsigned char* src = sm + GP_QD + (32 * tt + rr) * GP_LD + (32 * kt + 16 * s + 4 * h2) * 2;
            const v2u lo = *(const LAS v2u*)src, hi = *(const LAS v2u*)(src + 16);
            v4u o; o.x = lo.x; o.y = lo.y; o.z = hi.x; o.w = hi.y;
            *(v4u*)(qdf + (size_t)pi * 8) = o; }
    }
    __syncthreads();
}
__device__ __forceinline__ void gla_scan(LAS unsigned char* sm, const bf16* __restrict__ PROJ, const float* __restrict__ MPROJ, const bf16* __restrict__ QDF, const bf16* __restrict__ KDNTF, const bf16* __restrict__ SC,
                                         const float* __restrict__ EBL, const bf16* __restrict__ MQDF, const bf16* __restrict__ MKDNTF, const bf16* __restrict__ MSC, const float* __restrict__ MEBL,
                                         bf16* __restrict__ O, float* __restrict__ MO) {
    const int tid = threadIdx.x, wave = __builtin_amdgcn_readfirstlane(tid >> 6), lane = tid & 63, r = lane & 31, hh = lane >> 5, half = wave >> 2, js = wave & 3;
    const int sa_off = (r * 64 + 16 * js + 8 * hh) * 2;
    const int vt_ = lane, v8_ = wave * 8;
    const LAS unsigned char* vb0 = sm + GS_VT + (32 * half + r) * GS_VT_LD + 16 * hh;
    const LAS unsigned char* vb1 = sm + GS_VT + (32 * (half ^ 1) + r) * GS_VT_LD + 16 * hh;
    const LAS unsigned char* eb_rd = sm + GS_EB + (64 * wave + 4 * hh) * 4;
    LAS unsigned char* op_wr = sm + wave * 16384 + lane * 4;
    const int op_y0 = half * 4096, op_y1 = (half ^ 1) * 4096;
    const LAS unsigned char* op_rd = sm + (tid >> 4) * 256 + (tid & 15) * 16;
    const int red_t = 8 * ((tid >> 6) & 3) + 4 * ((tid >> 3) & 1) + ((tid >> 4) & 3), red_v = 32 * ((tid >> 8) & 1) + 4 * (tid & 7);
    for (int u0 = blockIdx.x; u0 < 256; u0 += gridDim.x) {
        const int u = gridDim.x == 256 ? ((u0 & 7) * 2 + (u0 >> 7)) * 16 + ((u0 >> 3) & 15) : u0;
        const int b = u >> 6, h = (u >> 4) & 3, vs = u & 15;
        f32x16 S00, S01, S10, S11;
#pragma unroll
        for (int i = 0; i < 16; ++i) { S00[i] = 0.f; S01[i] = 0.f; S10[i] = 0.f; S11[i] = 0.f; }
        bf16x8 qa[8], ka[8], sa[2]; v4u vreg; f32x4 ereg = {0.f, 0.f, 0.f, 0.f};
        const char* const mqf = (const char*)(MQDF + (size_t)h * GLA_ITEM_FR); const char* const mkf = (const char*)(MKDNTF + (size_t)h * GLA_ITEM_FR);
        const char* const msc = (const char*)(MSC + (size_t)h * 4096); const float* const meb = MEBL + h * DK;
#define GS_ITEM(c) const size_t it_ = ((size_t)b * 64 + (size_t)((c) > 0 ? (c) - 1 : 0)) * GH + h; \
            const char* qf_ = (c) == 0 ? mqf : (const char*)(QDF + it_ * GLA_ITEM_FR); const char* kf_ = (c) == 0 ? mkf : (const char*)(KDNTF + it_ * GLA_ITEM_FR); \
            const char* sc_ = (c) == 0 ? msc : (const char*)(SC + it_ * 4096); const float* eb_ = (c) == 0 ? meb : EBL + it_ * DK; (void)qf_; (void)kf_; (void)sc_; (void)eb_
#define GS_OPQ(name, val) int name##_i = (val); asm volatile("" : "+v"(name##_i)); const size_t name = (size_t)(unsigned)name##_i
#define GS_LOAD_Q(c) do { GS_ITEM(c); const char* qb_ = qf_ + wave * 8192; GS_OPQ(l16_, lane * 16); GS_OPQ(sao_, (int)sa_off); \
            _Pragma("unroll") for (int f = 0; f < 8; ++f) qa[f] = *(const bf16x8*)(qb_ + f * 1024 + l16_); \
            sa[0] = *(const bf16x8*)(sc_ + sao_); sa[1] = *(const bf16x8*)(sc_ + 4096 + sao_); } while (0)
#define GS_LOAD_K(c) do { GS_ITEM(c); const char* kb_ = kf_ + wave * 8192; GS_OPQ(l16_, lane * 16); \
            _Pragma("unroll") for (int j = 0; j < 8; ++j) ka[j] = *(const bf16x8*)(kb_ + j * 1024 + l16_); } while (0)
#define GS_LOAD_V(c) do { GS_ITEM(c); \
            if (tid < 128) { GS_OPQ(eo_, tid * 16); ereg = *(const f32x4*)((const char*)eb_ + eo_); } \
            if ((c) == 0) { if (vt_ >= 48) { GS_OPQ(vo_, ((vt_ - 48) * MGIN + v8_) * 4); const float* vp = (const float*)((const char*)(MPROJ + 2 * QK + h * DV + vs * 64) + vo_); const f32x4 x0 = *(const f32x4*)vp, x1 = *(const f32x4*)(vp + 4); \
                                  vreg.x = pk2(x0.x, x0.y); vreg.y = pk2(x0.z, x0.w); vreg.z = pk2(x1.x, x1.y); vreg.w = pk2(x1.z, x1.w); } else { vreg = (v4u){0u, 0u, 0u, 0u}; } } \
            else { GS_OPQ(vo_, (vt_ * NQKVR + v8_) * 2); vreg = *(const v4u*)((const char*)(PROJ + ((size_t)b * SEQ + (size_t)(((c) - 1) * 64)) * NQKVR + 2 * QK + h * DV + vs * 64) + vo_); } } while (0)
#define GS_STEP1() do { _Pragma("unroll") for (int e = 0; e < 8; ++e) { const unsigned wv = vreg[e >> 1]; *(LAS unsigned short*)(sm + GS_VT + (v8_ + e) * GS_VT_LD + vt_ * 2) = (unsigned short)((e & 1) ? (wv >> 16) : (wv & 0xffffu)); } \
            if (tid < 128) *((LAS f32x4*)(sm + GS_EB) + tid) = ereg; } while (0)
        GS_LOAD_V(0); GS_LOAD_Q(0);
        GS_STEP1();
#pragma unroll 1
        for (int c = 0; c <= 64; ++c) {
            __syncthreads();
            GS_LOAD_K(c);
            if (c < 64) GS_LOAD_V(c + 1);
            __builtin_amdgcn_sched_barrier(0);
#define GS_OHALF(Sa, Sb, vbp, sfrag, tsel, opy) do { f32x16 o0, o1; _Pragma("unroll") for (int i = 0; i < 16; ++i) { o0[i] = 0.f; o1[i] = 0.f; } \
              _Pragma("unroll") for (int s = 0; s < 2; ++s) { const bf16x8 sb = pack_step(Sa, s); o0 = MFMA32(qa[s * 2 + 0], sb, o0); o1 = MFMA32(qa[s * 2 + 1], sb, o1); } \
              _Pragma("unroll") for (int s = 0; s < 2; ++s) { const bf16x8 sb = pack_step(Sb, s); o0 = MFMA32(qa[4 + s * 2 + 0], sb, o0); o1 = MFMA32(qa[4 + s * 2 + 1], sb, o1); } \
              { const bf16x8 vI = *(const LAS bf16x8*)((vbp) + js * 32); if (tsel == 0) o0 = MFMA32(sfrag, vI, o0); else o1 = MFMA32(sfrag, vI, o1); } \
              _Pragma("unroll") for (int i = 0; i < 16; ++i) { *(LAS float*)(op_wr + (opy) + i * 256) = o0[i]; *(LAS float*)(op_wr + 8192 + (opy) + i * 256) = o1[i]; } \
              __builtin_amdgcn_sched_barrier(0); } while (0)
            GS_OHALF(S00, S10, vb0, sa[0], 0, op_y0);
            GS_OHALF(S01, S11, vb1, sa[1], 1, op_y1);
            {
              bf16x8 vB0[4], vB1[4];
#pragma unroll
              for (int ts = 0; ts < 4; ++ts) { vB0[ts] = *(const LAS bf16x8*)(vb0 + ts * 32); vB1[ts] = *(const LAS bf16x8*)(vb1 + ts * 32); }
              f32x4 ea[4], ec[4];
#define GS_EBLD(e, kt) do { _Pragma("unroll") for (int g4 = 0; g4 < 4; ++g4) e[g4] = *(const LAS f32x4*)(eb_rd + (32 * (kt) + 8 * g4) * 4); } while (0)
#define GS_EBMUL(Sx, e) do { _Pragma("unroll") for (int g4 = 0; g4 < 4; ++g4) { Sx[4 * g4 + 0] *= e[g4].x; Sx[4 * g4 + 1] *= e[g4].y; Sx[4 * g4 + 2] *= e[g4].z; Sx[4 * g4 + 3] *= e[g4].w; } \
                asm volatile("" : "+v"(Sx));     } while (0)
              GS_EBLD(ea, 0); GS_EBLD(ec, 1);
#pragma unroll
              for (int ts = 0; ts < 4; ++ts) {
                S00 = MFMA32(ka[ts], vB0[ts], S00); S01 = MFMA32(ka[ts], vB1[ts], S01); S10 = MFMA32(ka[4 + ts], vB0[ts], S10); S11 = MFMA32(ka[4 + ts], vB1[ts], S11); }
              __builtin_amdgcn_sched_barrier(0);
              if (c < 64) GS_LOAD_Q(c + 1);
              __builtin_amdgcn_sched_barrier(0);
              GS_EBMUL(S00, ea); GS_EBMUL(S01, ea); __builtin_amdgcn_sched_barrier(0);
              GS_EBMUL(S10, ec); GS_EBMUL(S11, ec); __builtin_amdgcn_sched_barrier(0);
#undef GS_EBLD
#undef GS_EBMUL
            }
            __syncthreads();
            if (c < 64) GS_STEP1();
            { int lo = (red_t * GV + red_v) * 2; asm volatile("" : "+v"(lo));
              const char* const ob = (const char*)(O + ((size_t)b * SEQ + (size_t)((c > 0 ? c - 1 : 0) * 64)) * GV + h * DV + vs * 64);
#pragma unroll
              for (int p = 0; p < 2; ++p) {
                f32x4 s4 = *(const LAS f32x4*)(op_rd + p * 8192);
#pragma unroll
                for (int w8 = 1; w8 < 8; ++w8) { const f32x4 x = *(const LAS f32x4*)(op_rd + w8 * 16384 + p * 8192); s4.x += x.x; s4.y += x.y; s4.z += x.z; s4.w += x.w; }
                if (p == 1 && c == 0 && b == 0 && red_t >= 16) *(f32x4*)(MO + (size_t)(red_t - 16) * GV + h * DV + vs * 64 + red_v) = s4;
                { v2u w; w.x = pk2(s4.x, s4.y); w.y = pk2(s4.z, s4.w); *(v2u*)(ob + (size_t)p * (32 * GV * 2) + lo) = w; } } }
            __builtin_amdgcn_sched_barrier(0);
        }
#undef GS_ITEM
#undef GS_LOAD_Q
#undef GS_LOAD_K
#undef GS_LOAD_V
#undef GS_OPQ
#undef GS_OHALF
#undef GS_STEP1
        __syncthreads();
    }
}

template <bool OBF>
__device__ __forceinline__ void gate_item(const void* orow  , const float* __restrict__ hn, f32x4 (&rv)[4], bf16* og, int lane) {
    f32x4 v[4]; float s = 0.f;
#pragma unroll
    for (int j = 0; j < 4; ++j) {
        if (OBF) { const v2u w = *((const v2u*)orow + lane + 64 * j); v[j] = (f32x4){bflo(w.x), bfhi(w.x), bflo(w.y), bfhi(w.y)}; }
        else v[j] = *((const f32x4*)orow + lane + 64 * j);
        s += (v[j].x * v[j].x + v[j].y * v[j].y) + (v[j].z * v[j].z + v[j].w * v[j].w); }
    const float rs = 1.0f / sqrtf(wave_sum(s) * (1.0f / DV) + EPS);
#pragma unroll
    for (int j = 0; j < 4; ++j) { const f32x4 g = *((const f32x4*)hn + lane + 64 * j);
        v2u w; w.x = pk2(v[j].x * rs * g.x * silu_f(rv[j].x), v[j].y * rs * g.y * silu_f(rv[j].y)); w.y = pk2(v[j].z * rs * g.z * silu_f(rv[j].z), v[j].w * rs * g.w * silu_f(rv[j].w));
        *((v2u*)og + lane + 64 * j) = w; }
}

struct Args { const float* in[16]; float* out; unsigned char* ws; int ph_lo, ph_hi, li, pad; };
enum { I_X = 0, I_META, I_NMIX, I_NFFN, I_GWIN, I_GWA2, I_GBA, I_GHN, I_GWOUT, I_CWIN, I_CW, I_CWOUT, I_FGATE, I_FUP, I_FDOWN, I_NFINAL };

__global__ void __launch_bounds__(NWAVES * 64, 2) trunk_fwd(Args args) {
    extern __shared__ __attribute__((aligned(16))) unsigned char lds_raw[];
    LAS unsigned char* lds = (LAS unsigned char*)lds_raw;
    volatile LAS unsigned* MISC = (volatile LAS unsigned*)(lds + MISC_OFF);
    const int tid = threadIdx.x, lane = tid & 63, wave = __builtin_amdgcn_readfirstlane(tid >> 6);
    const int G = gridDim.x, bx = blockIdx.x;
    const int gw = bx * NWAVES + wave, NGW = G * NWAVES;
    unsigned char* ws = args.ws;
    unsigned* ctl = (unsigned*)(ws + WS_CTL);
    float* SS = (float*)ctl + CW_SS; float* MSS = (float*)ctl + CW_MSS; float* SSP = (float*)(ws + WS_SSP); constexpr size_t SSP_N = (size_t)64 * 16 * 256 * 4;
    const float* x = args.in[I_X]; float* out = args.out;
    bf16* W_GIN = (bf16*)(ws + WS_WGIN); bf16* W_GOUT = (bf16*)(ws + WS_WGOUT); bf16* W_GU0 = (bf16*)(ws + WS_WGU0); bf16* W_DN0 = (bf16*)(ws + WS_WDN0);
    bf16* W_CIN = (bf16*)(ws + WS_WCIN); bf16* W_COUT = (bf16*)(ws + WS_WCOUT); bf16* W_GU1 = (bf16*)(ws + WS_WGU1); bf16* W_DN1 = (bf16*)(ws + WS_WDN1);
    bf16* XB = (bf16*)(ws + WS_XB); bf16* OG = (bf16*)(ws + WS_OG); bf16* PROJ = (bf16*)(ws + WS_PROJ); bf16* ACT = PROJ; bf16* CBG = PROJ; bf16* CZ = PROJ + (size_t)M * D;
    bf16* O = (bf16*)(ws + WS_O); float* ALOW = (float*)(ws + WS_ALOW);
    bf16* QDF = (bf16*)(ws + WS_QDF); bf16* KDNTF = (bf16*)(ws + WS_KDNTF); bf16* SC = (bf16*)(ws + WS_SC); float* EBL = (float*)(ws + WS_EBL);
    unsigned char* mt = ws + WS_META;
    bf16* MXB = (bf16*)(mt + MT_XB); float* MPROJ = (float*)(mt + MT_PROJ); float* MO = (float*)(mt + MT_O); bf16* MOG = (bf16*)(mt + MT_OG); float* MH = (float*)(mt + MT_H);
    bf16* MACT = (bf16*)(mt + MT_ACT); float* ZM = (float*)(mt + MT_Z);
    bf16* MQDF = (bf16*)(mt + MT_QDF); bf16* MKDNTF = (bf16*)(mt + MT_KDNTF); bf16* MSC = (bf16*)(mt + MT_SC); float* MEBL = (float*)(mt + MT_EBL);

    for (int u = tid; u < 1024 / 4; u += NWAVES * 64) ((LAS unsigned*)(lds + LDSCTL_OFF))[u] = 0u;
    __syncthreads();
    const int lo = args.ph_lo, hi = args.ph_hi;
    XcdBarrier bar; bar.bar = ctl + CW_BAR + args.li * XCD_BAR_WORDS; bar.x = 0; bar.st = nullptr;
    if (hi - lo > 1) bar = xcd_barrier_post(ctl + CW_BAR + args.li * XCD_BAR_WORDS, MISC + 8);
#ifndef ONLY_PHASE
#define ONLY_PHASE -1
#endif
#define IN(k) (lo <= (k) && (k) < hi && (ONLY_PHASE < 0 || (k) == ONLY_PHASE))
#define SEAM(k) do { if (IN(k) && IN((k) + 1)) xcd_barrier(bar); } while (0)

    if (IN(0)) {
        LAS float* scr = (LAS float*)(lds + RING_OFF + wave * 16384);
        cvt_task<0>(args.in[I_GWIN], D, GIN, GIN, args.in[I_NMIX], W_GIN, scr, gw, NGW, lane);
        cvt_task<0>(args.in[I_GWOUT], GV, D, D, nullptr, W_GOUT, scr, gw, NGW, lane);
        cvt_task<1>(args.in[I_FGATE], D, FF, FF, args.in[I_NFFN], W_GU0, scr, gw, NGW, lane);
        cvt_task<2>(args.in[I_FUP], D, FF, FF, args.in[I_NFFN], W_GU0, scr, gw, NGW, lane);
        cvt_task<0>(args.in[I_FDOWN], FF, D, D, nullptr, W_DN0, scr, gw, NGW, lane);
        cvt_task<0>(args.in[I_CWIN], D, NQKVR, D, args.in[I_NMIX] + D, W_CIN, scr, gw, NGW, lane);
        cvt_task<1>(args.in[I_CWIN] + D, D, NQKVR, D, args.in[I_NMIX] + D, W_CIN + (size_t)D * D, scr, gw, NGW, lane);
        cvt_task<2>(args.in[I_CWIN] + 2 * D, D, NQKVR, D, args.in[I_NMIX] + D, W_CIN + (size_t)D * D, scr, gw, NGW, lane);
        cvt_task<0>(args.in[I_CWOUT], D, D, D, nullptr, W_COUT, scr, gw, NGW, lane);
        cvt_task<1>(args.in[I_FGATE] + (size_t)D * FF, D, FF, FF, args.in[I_NFFN] + D, W_GU1, scr, gw, NGW, lane);
        cvt_task<2>(args.in[I_FUP] + (size_t)D * FF, D, FF, FF, args.in[I_NFFN] + D, W_GU1, scr, gw, NGW, lane);
        cvt_task<0>(args.in[I_FDOWN] + (size_t)FF * D, FF, D, D, nullptr, W_DN1, scr, gw, NGW, lane);
        for (int blk = bx; blk < M / 64; blk += G)
            for (int i = 0; i < 8; ++i) { const int m = blk * 64 + wave * 8 + i; row_to_bf16_ss(x + (size_t)m * D, XB + (size_t)m * D, SS + m, lane); }
        if (bx == 0) for (int i = 0; i < 2; ++i) { const int m = wave * 2 + i; row_to_bf16_ss(args.in[I_META] + (size_t)m * D, MXB + (size_t)m * D, MSS + m, lane); }
        for (int oc = bx; oc < NMETA * GR; oc += G) {
            const int r = oc >> 4, c = oc & 15; const float* mr = args.in[I_META] + (size_t)r * D; const float* gm = args.in[I_NMIX]; const float* wi = args.in[I_GWIN] + NQKVR + c;
            float ssq = 0.f, acc = 0.f;
#pragma unroll
            for (int j = 0; j < 8; ++j) { const int k = tid + 512 * j; const float xv = mr[k]; ssq += xv * xv; acc += xv * gm[k] * wi[(size_t)k * GIN]; }
            ssq = wave_sum(ssq); acc = wave_sum(acc);
            LAS float* rd = (LAS float*)(lds + RING_OFF + 8 * 16384);
            __syncthreads(); if (lane == 0) { rd[wave] = ssq; rd[8 + wave] = acc; } __syncthreads();
            if (tid == 0) { float s2 = 0.f, a2 = 0.f; for (int w = 0; w < 8; ++w) { s2 += rd[w]; a2 += rd[8 + w]; } MPROJ[(size_t)r * MGIN + NQKVR + c] = a2 * rstd_of(s2); } }
    }
    SEAM(0);

    if (IN(1)) {
        { TE_ALow e{ALOW, SS}; thin_gemm16<false>(lds + RING_OFF, W_GIN + (size_t)NQKVR * D, XB, D, M / 16, 0, e, bx, G); }
        { LAS float* rt = (LAS float*)(lds + RING_OFF + 16384); thin_row_rstd(rt, args.in[I_META]); TE_MProj e{MPROJ, rt}; thin_gemm16<false>(lds + RING_OFF, MXB, W_GIN, D, NQKVR / 16, 0, e, bx, G); }
        pg8::Gemm g{XB, W_GIN, M, NQKVR, D}; pg8::RstdOrder S; S.init(M, NQKVR, G, bx); S.ssp = nullptr; S.ss0 = SS; S.npn = 0; S.cnt = 0;
        pg8::EpiScaleBf16 E{PROJ, NQKVR, 0};
        pg8::gemm_phase<pg8::EpiScaleBf16, pg8::RstdOrder, true, true>(lds + RING_OFF, g, S, E);
    }
    SEAM(1);

    if (IN(2)) {
        LAS unsigned char* sm = lds + RING_OFF;
        if (bx < GH) gla_prep_item(sm, true, PROJ, ALOW, MPROJ, bx, args.in[I_GWA2], args.in[I_GBA], MQDF + (size_t)bx * GLA_ITEM_FR, MKDNTF + (size_t)bx * GLA_ITEM_FR, MSC + (size_t)bx * 4096, MEBL + bx * DK);
        for (int it = bx; it < NB * 64 * GH; it += G) { const int h = it & 3; const size_t m0 = (size_t)(it >> 2) * 64;
            gla_prep_item(sm, false, PROJ + m0 * NQKVR, ALOW + m0 * 16, MPROJ, h, args.in[I_GWA2], args.in[I_GBA], QDF + (size_t)it * GLA_ITEM_FR, KDNTF + (size_t)it * GLA_ITEM_FR, SC + (size_t)it * 4096, EBL + (size_t)it * DK); }
    }
    SEAM(2);

#ifndef NO_SCAN
    if (IN(3)) gla_scan(lds + RING_OFF, PROJ, MPROJ, QDF, KDNTF, SC, EBL, MQDF, MKDNTF, MSC, MEBL, O, MO);
#endif
    SEAM(3);

    if (IN(4)) {
        const float* hn = args.in[I_GHN];
        for (int it = gw; it < M * GH; it += NGW) { const int m = it >> 2, h = it & 3; f32x4 rv[4];
            const v2u* rp = (const v2u*)(PROJ + (size_t)m * NQKVR + 2 * QK + GV + h * DV);
#pragma unroll
            for (int j = 0; j < 4; ++j) { const v2u w = rp[lane + 64 * j]; rv[j] = (f32x4){bflo(w.x), bfhi(w.x), bflo(w.y), bfhi(w.y)}; }
            gate_item<true>(O + (size_t)m * GV + h * DV, hn, rv, OG + (size_t)m * GV + h * DV, lane); }
        if (gw < NMETA * GH) { const int m = gw >> 2, h = gw & 3; f32x4 rv[4];
#pragma unroll
            for (int j = 0; j < 4; ++j) rv[j] = *((const f32x4*)(MPROJ + (size_t)m * MGIN + 2 * QK + GV + h * DV) + lane + 64 * j);
            gate_item<false>(MO + (size_t)m * GV + h * DV, hn, rv, MOG + (size_t)m * GV + h * DV, lane); }
    }
    SEAM(4);

    if (IN(5)) {
        { TE_MResid e{args.in[I_META], MH, MXB, MSS + MSS_STRIDE}; thin_gemm16<false>(lds + RING_OFF, MOG, W_GOUT, GV, D / 16, 0, e, bx, G); }
        pg8::Gemm g{OG, W_GOUT, M, D, GV}; pg8::StaticOrder S; S.init(M, D, G, bx);
        pg8::EpiResid<false> E{x, XB, SSP, D};
        pg8::gemm_phase<pg8::EpiResid<false>, pg8::StaticOrder, true, true>(lds + RING_OFF, g, S, E);
    }
    SEAM(5);

    if (IN(6)) {
        const bool thin_in_tail = G == 256;
        if (!thin_in_tail) { LAS float* rt = (LAS float*)(lds + RING_OFF + 16384); thin_row_rstd(rt, MH); TE_MSwiGLU e{MACT, rt}; thin_gemm16<true>(lds + RING_OFF, MXB, W_GU0, D, FF / 16, 128, e, bx, G); }
        pg8::Gemm g{XB, W_GU0, M, NGU, D}; pg8::RstdOrder S; S.init(M, NGU, G, bx); S.ssp = SSP; S.ss0 = nullptr; S.npn = D / 256; S.cnt = 0;
        pg8::EpiSwiGLU E{ACT, FF, 0};
        pg8::gemm_phase<pg8::EpiSwiGLU, pg8::RstdOrder, true, true>(lds + RING_OFF, g, S, E);
        if (thin_in_tail && bx >= 128) { __syncthreads();
            LAS float* rt = (LAS float*)(lds + RING_OFF + 16384); thin_row_rstd(rt, MH); TE_MSwiGLU e{MACT, rt}; thin_gemm16<true>(lds + RING_OFF, MXB, W_GU0, D, FF / 16, 128, e, bx - 128, 128); }
    }
    SEAM(6);

    if (IN(7)) {
        { TE_MResid e{MH, MH, MXB, MSS + 2 * MSS_STRIDE}; thin_gemm16<false>(lds + RING_OFF, MACT, W_DN0, FF, D / 16, 0, e, bx, G); }
        pg8::Gemm g{ACT, W_DN0, M, D, FF}; pg8::StaticOrderPN S; S.init(M, D, G, bx);
        pg8::EpiResid<true> E{nullptr, XB, SSP + SSP_N, D};
        pg8::gemm_phase<pg8::EpiResid<true>, pg8::StaticOrderPN, true, true>(lds + RING_OFF, g, S, E);
    }
    SEAM(7);

    if (IN(8)) {
        { LAS float* rt = (LAS float*)(lds + RING_OFF + 16384); thin_row_rstd(rt, MH); TE_MConvZ e{ZM, rt}; thin_gemm16<true>(lds + RING_OFF, MXB, W_CIN, D, D / 16, 128, e, bx, G); }
        { pg8::Gemm g{XB, W_CIN, M, D, D}; pg8::RstdOrder S; S.init(M, D, G, bx); S.ssp = SSP + SSP_N; S.ss0 = nullptr; S.npn = D / 256; S.cnt = 0;
          pg8::EpiScaleBf16 E{CBG, D, 0};
          pg8::gemm_phase<pg8::EpiScaleBf16, pg8::RstdOrder, true, true>(lds + RING_OFF, g, S, E); }
        __syncthreads();
        { pg8::Gemm g{XB, W_CIN + (size_t)D * D, M, 2 * D, D}; pg8::RstdOrder S; S.init(M, 2 * D, G, bx); S.ssp = SSP + SSP_N; S.ss0 = nullptr; S.npn = D / 256; S.cnt = 0;
          pg8::EpiMul E{CZ, D, 0};
          pg8::gemm_phase<pg8::EpiMul, pg8::RstdOrder, true, true>(lds + RING_OFF, g, S, E); }
    }
    SEAM(8);

    if (IN(9)) {
        const float* cw = args.in[I_CW];
        const int c0 = tid * 8;
        float w0[8], w1[8], w2[8];
#pragma unroll
        for (int j = 0; j < 8; ++j) { w0[j] = cw[c0 + j]; w1[j] = cw[D + c0 + j]; w2[j] = cw[2 * D + c0 + j]; }
        for (int run = bx; run < M / 64; run += G) {
            const int m0 = run * 64, s0 = m0 & (SEQ - 1);
            float z1[8], z2[8];
            if (s0 == 0) {
#pragma unroll
                for (int j = 0; j < 8; ++j) { z2[j] = ZM[c0 + j]; z1[j] = ZM[D + c0 + j]; }
            } else {
                const v4u zq2 = *(const v4u*)(CZ + (size_t)(m0 - 2) * D + c0), zq1 = *(const v4u*)(CZ + (size_t)(m0 - 1) * D + c0);
#pragma unroll
                for (int j = 0; j < 4; ++j) { z2[2 * j] = bflo(zq2[j]); z2[2 * j + 1] = bfhi(zq2[j]); z1[2 * j] = bflo(zq1[j]); z1[2 * j + 1] = bfhi(zq1[j]); }
            }
#pragma unroll 4
            for (int rr = 0; rr < 64; ++rr) {
                const v4u bg = *(const v4u*)(CBG + (size_t)(m0 + rr) * D + c0), zq = *(const v4u*)(CZ + (size_t)(m0 + rr) * D + c0);
                float z[8], y[8];
#pragma unroll
                for (int j = 0; j < 4; ++j) { z[2 * j] = bflo(zq[j]); z[2 * j + 1] = bfhi(zq[j]); }
#pragma unroll
                for (int j = 0; j < 8; ++j) { const float cv = w2[j] * z[j] + w1[j] * z1[j] + w0[j] * z2[j]; const float bgf = (j & 1) ? bfhi(bg[j >> 1]) : bflo(bg[j >> 1]); y[j] = bgf * cv; z2[j] = z1[j]; z1[j] = z[j]; }
                v4u o; o.x = pk2(y[0], y[1]); o.y = pk2(y[2], y[3]); o.z = pk2(y[4], y[5]); o.w = pk2(y[6], y[7]);
                *(v4u*)(OG + (size_t)(m0 + rr) * D + c0) = o;
            }
        }
    }
    SEAM(9);

    if (IN(10)) {
        pg8::Gemm g{OG, W_COUT, M, D, D}; pg8::StaticOrder S; S.init(M, D, G, bx);
        pg8::EpiResid<true> E{nullptr, XB, SSP + 2 * SSP_N, D};
        pg8::gemm_phase<pg8::EpiResid<true>, pg8::StaticOrder, true, true>(lds + RING_OFF, g, S, E);
    }
    SEAM(10);

    if (IN(11)) {
        pg8::Gemm g{XB, W_GU1, M, NGU, D}; pg8::RstdOrder S; S.init(M, NGU, G, bx); S.ssp = SSP + 2 * SSP_N; S.ss0 = nullptr; S.npn = D / 256; S.cnt = 0;
        pg8::EpiSwiGLU E{ACT, FF, 0};
        pg8::gemm_phase<pg8::EpiSwiGLU, pg8::RstdOrder, true, true>(lds + RING_OFF, g, S, E);
    }
    SEAM(11);

    if (IN(12)) {
        pg8::Gemm g{ACT, W_DN1, M, D, FF}; pg8::StaticOrderPN S; S.init(M, D, G, bx);
        pg8::EpiResid<true> E{nullptr, XB, SSP, D};
        pg8::gemm_phase<pg8::EpiResid<true>, pg8::StaticOrderPN, true, true>(lds + RING_OFF, g, S, E);
    }
    SEAM(12);

    if (IN(13)) {
        const float* gf = args.in[I_NFINAL];
        bool bad = false;
        for (int r = 0; r < N_PHASES; ++r) bad |= __hip_atomic_load(ctl + CW_BAR + r * XCD_BAR_WORDS + XB_TMO, __ATOMIC_RELAXED, __HIP_MEMORY_SCOPE_AGENT) != 0u;
        for (int m = gw; m < M; m += NGW) { const v4u* xr = (const v4u*)(XB + (size_t)m * D) + lane; f32x4* row = (f32x4*)(out + (size_t)m * D) + 2 * lane; v4u q[8]; float ssq = 0.f;
#pragma unroll
            for (int j = 0; j < 8; ++j) { q[j] = xr[64 * j];
#pragma unroll
                for (int e = 0; e < 4; ++e) { const float lo = bflo(q[j][e]), hi = bfhi(q[j][e]); ssq += lo * lo + hi * hi; } }
            const float rs = bad ? __builtin_nanf("") : rstd_of(wave_sum(ssq));
#pragma unroll
            for (int j = 0; j < 8; ++j) { const f32x4 g0 = *((const f32x4*)gf + 2 * lane + 128 * j), g1 = *((const f32x4*)gf + 2 * lane + 128 * j + 1);
                f32x4 o0, o1; o0.x = bflo(q[j].x) * rs * g0.x; o0.y = bfhi(q[j].x) * rs * g0.y; o0.z = bflo(q[j].y) * rs * g0.z; o0.w = bfhi(q[j].y) * rs * g0.w;
                o1.x = bflo(q[j].z) * rs * g1.x; o1.y = bfhi(q[j].z) * rs * g1.y; o1.z = bflo(q[j].w) * rs * g1.z; o1.w = bfhi(q[j].w) * rs * g1.w;
                row[128 * j] = o0; row[128 * j + 1] = o1; } }
    }
#undef IN
#undef SEAM
}

extern "C" void kernel_launch(void* const* d_in, const int* in_sizes, int n_in, void* d_out, int out_size, void* d_ws, size_t ws_size, hipStream_t stream) {
    static int grid = 0;
    if (grid == 0) {
        if (n_in != 16 || in_sizes[0] != M * D || out_size != M * D || ws_size < WS_END) { fprintf(stderr, "kernel_launch: unexpected problem (n_in %d, in0 %d, out %d, ws %zu < %zu)\n", n_in, n_in > 0 ? in_sizes[0] : -1, out_size, ws_size, (size_t)WS_END); grid = -1; return; }
        int dev = 0, cus = 0, per_cu = 0;
        if (hipGetDevice(&dev) != hipSuccess || hipDeviceGetAttribute(&cus, hipDeviceAttributeMultiprocessorCount, dev) != hipSuccess) { grid = -1; return; }
        if (hipFuncSetAttribute((const void*)trunk_fwd, hipFuncAttributeMaxDynamicSharedMemorySize, LDS_BYTES) != hipSuccess) { fprintf(stderr, "kernel_launch: hipFuncSetAttribute failed\n"); grid = -1; return; }
        if (hipOccupancyMaxActiveBlocksPerMultiprocessor(&per_cu, (const void*)trunk_fwd, NWAVES * 64, LDS_BYTES) != hipSuccess || per_cu < 1)
            fprintf(stderr, "kernel_launch: note: occupancy query reports %d workgroups per CU\n", per_cu);
        (void)hipGetLastError();
        grid = cus;
    }
    if (grid < 0) return;
#if DIAG_POISON
    (void)hipMemsetAsync((char*)d_ws + CTL_ZERO_BYTES, 0xAA, WS_END - CTL_ZERO_BYTES, stream);
    (void)hipMemsetAsync(d_out, 0xAA, (size_t)M * D * 4, stream);
#endif
    if (hipMemsetAsync((char*)d_ws + WS_CTL, 0, CTL_ZERO_BYTES, stream) != hipSuccess) { fprintf(stderr, "kernel_launch: memset failed\n"); return; }
    Args a{};
    for (int i = 0; i < 16; ++i) a.in[i] = (const float*)d_in[i];
    a.out = (float*)d_out; a.ws = (unsigned char*)d_ws;
    int li = 0;
    for (int p0 = 0; p0 < N_PHASES; ++li) {
        int p1 = p0 + 1; while (p1 < N_PHASES && !((MK_CUTS >> (p1 - 1)) & 1u)) ++p1;
        a.ph_lo = p0; a.ph_hi = p1; a.li = li; p0 = p1;
        hipLaunchKernelGGL(trunk_fwd, dim3(grid), dim3(NWAVES * 64), LDS_BYTES, stream, a);
        const hipError_t le = hipPeekAtLastError();
        if (le != hipSuccess) { fprintf(stderr, "kernel_launch: launch %d failed: %s\n", li, hipGetErrorName(le)); break; }
    }
}
```

```cpp
#include <hip/hip_runtime.h>
#include <cstdio>
#include <cstdint>
namespace pg8 {
#define PG8_LAS __attribute__((address_space(3)))
typedef unsigned short bf16_t;
typedef short bf16x8 __attribute__((ext_vector_type(8)));
typedef float f32x4 __attribute__((ext_vector_type(4)));
typedef unsigned u32x4 __attribute__((ext_vector_type(4)));
constexpr int BM = 256, BK = 64, HALF = 128, HTB = HALF * BK * 2  , STAGE_BYTES = 8 * HTB, NXCD = 8, WGM = 8;

__host__ __device__ __forceinline__ int lds_byte(int r, int c) { const int st = (r >> 4) * 2 + (c >> 5), rr = r & 15, cc = c & 31, ob = rr * 64 + cc * 2; return st * 1024 + (ob ^ (((ob >> 9) & 1) << 5)); }
__host__ __device__ __forceinline__ void stage_rc(int b, int& R, int& C) { const int st = b / 1024, sb = b % 1024, swz = sb ^ (((sb >> 9) & 1) << 5); R = (st >> 1) * 16 + swz / 64; C = (st & 1) * 32 + (swz % 64) / 2; }
__host__ __device__ __forceinline__ int perm32(int rho) { const int n = rho >> 4, i = rho & 15; return 8 * (i >> 2) + 4 * n + (i & 3); }

struct Unit { int pm, pn; };
struct Gemm { const bf16_t* A; const bf16_t* Bt; int M, N, K; };

struct StaticOrder {
    int nM, nN, nwg, G, c;
    __host__ __device__ void init(int M, int N, int G_, int c_) { nM = M / BM; nN = N / BM; nwg = nM * nN; G = G_; c = c_; }
    __host__ __device__ bool next(int i, Unit& u) const {
        const long L = (long)i * G + c; if (L >= nwg) return false;
        int wgid = (int)L; { const int q = nwg / NXCD, r = nwg % NXCD, xcd = wgid % NXCD, off = wgid / NXCD; wgid = (xcd < r ? xcd * (q + 1) : r * (q + 1) + (xcd - r) * q) + off; }
        const int nig = WGM * nN, gid = wgid / nig, fm = gid * WGM, gsz = (nM - fm) < WGM ? (nM - fm) : WGM;
        u.pm = fm + ((wgid % nig) % gsz); u.pn = (wgid % nig) / gsz; return true;
    }
    __device__ __forceinline__ void a_ready(const Unit&) const {}
    __device__ __forceinline__ void first_ready(const Unit&) const {}
    __device__ __forceinline__ void done(const Unit&) const {}
    __device__ __forceinline__ void after_epi(const Unit&) const {}
};


struct StaticOrderPN : StaticOrder {
    __host__ __device__ bool next(int i, Unit& u) const {
        const long L = (long)i * G + c; if (L >= nwg) return false;
        int wgid = (int)L; { const int q = nwg / NXCD, r = nwg % NXCD, xcd = wgid % NXCD, off = wgid / NXCD; wgid = (xcd < r ? xcd * (q + 1) : r * (q + 1) + (xcd - r) * q) + off; }
        const int nig = WGM * nN, gid = wgid / nig, fm = gid * WGM, idx = wgid % nig;
        u.pm = fm + idx / nN; u.pn = idx % nN; return true;
    }
};

__device__ __forceinline__ unsigned cvt_pk_bf16(float lo, float hi) { unsigned r; asm volatile("v_cvt_pk_bf16_f32 %0, %1, %2" : "=v"(r) : "v"(lo), "v"(hi)); return r; }
__device__ __forceinline__ float rstd_of(float ss) { return 1.0f / sqrtf(ss * (1.0f / 4096.0f) + 1e-6f); }
__device__ __forceinline__ float silu_f(float x) { return x * __builtin_amdgcn_rcpf(1.0f + __expf(-x)); }

struct EpiScaleBf16 {
    static constexpr bool PERM = true, AFTER_DRAIN = false;
    bf16_t* O; int ldc; mutable int cnt;
    __device__ __forceinline__ void operator()(const f32x4 (&acc)[2][2][4][2], const Unit& u, int wr, int wc, int fr, int fq) const {
        const int row0 = u.pm * BM + wr * 64 + fr, col0 = u.pn * BM + wc * 32 + 8 * fq; const PG8_LAS float* tb = (const PG8_LAS float*)(unsigned)131072 + (cnt & 1) * 256 + wr * 64 + fr; ++cnt;
#pragma unroll
        for (int ai = 0; ai < 2; ++ai)
#pragma unroll
            for (int m = 0; m < 4; ++m) { const int row = row0 + ai * HALF + m * 16; const float sc = tb[ai * HALF + m * 16]; bf16_t* rowp = O + (size_t)row * ldc + col0;
#pragma unroll
                for (int bj = 0; bj < 2; ++bj) { const f32x4 v0 = acc[ai][bj][m][0] * sc, v1 = acc[ai][bj][m][1] * sc;
                    u32x4 w; w.x = cvt_pk_bf16(v0[0], v0[1]); w.y = cvt_pk_bf16(v0[2], v0[3]); w.z = cvt_pk_bf16(v1[0], v1[1]); w.w = cvt_pk_bf16(v1[2], v1[3]);
                    *(u32x4*)(rowp + bj * HALF) = w; } }
    }
};
struct EpiSwiGLU {
    static constexpr bool PERM = true, AFTER_DRAIN = false;
    bf16_t* O; int ldc; mutable int cnt;
    __device__ __forceinline__ void operator()(const f32x4 (&acc)[2][2][4][2], const Unit& u, int wr, int wc, int fr, int fq) const {
        const int row0 = u.pm * BM + wr * 64 + fr, col0 = u.pn * HALF + wc * 32 + 8 * fq; const PG8_LAS float* tb = (const PG8_LAS float*)(unsigned)131072 + (cnt & 1) * 256 + wr * 64 + fr; ++cnt;
#pragma unroll
        for (int ai = 0; ai < 2; ++ai)
#pragma unroll
            for (int m = 0; m < 4; ++m) { const int row = row0 + ai * HALF + m * 16; const float sc = tb[ai * HALF + m * 16];
                float a[8];
#pragma unroll
                for (int n = 0; n < 2; ++n)
#pragma unroll
                    for (int j = 0; j < 4; ++j) { const float g = acc[ai][0][m][n][j] * sc, up = acc[ai][1][m][n][j] * sc; a[4 * n + j] = silu_f(g) * up; }
                u32x4 w; w.x = cvt_pk_bf16(a[0], a[1]); w.y = cvt_pk_bf16(a[2], a[3]); w.z = cvt_pk_bf16(a[4], a[5]); w.w = cvt_pk_bf16(a[6], a[7]);
                *(u32x4*)(O + (size_t)row * ldc + col0) = w; }
    }
};
struct EpiMul {
    static constexpr bool PERM = true, AFTER_DRAIN = false;
    bf16_t* O; int ldc; mutable int cnt;
    __device__ __forceinline__ void operator()(const f32x4 (&acc)[2][2][4][2], const Unit& u, int wr, int wc, int fr, int fq) const {
        const int row0 = u.pm * BM + wr * 64 + fr, col0 = u.pn * HALF + wc * 32 + 8 * fq; const PG8_LAS float* tb = (const PG8_LAS float*)(unsigned)131072 + (cnt & 1) * 256 + wr * 64 + fr; ++cnt;
#pragma unroll
        for (int ai = 0; ai < 2; ++ai)
#pragma unroll
            for (int m = 0; m < 4; ++m) { const int row = row0 + ai * HALF + m * 16; const float sc = tb[ai * HALF + m * 16], sc2 = sc * sc;
                float a[8];
#pragma unroll
                for (int n = 0; n < 2; ++n)
#pragma unroll
                    for (int j = 0; j < 4; ++j) a[4 * n + j] = (acc[ai][0][m][n][j] * acc[ai][1][m][n][j]) * sc2;
                u32x4 w; w.x = cvt_pk_bf16(a[0], a[1]); w.y = cvt_pk_bf16(a[2], a[3]); w.z = cvt_pk_bf16(a[4], a[5]); w.w = cvt_pk_bf16(a[6], a[7]);
                *(u32x4*)(O + (size_t)row * ldc + col0) = w; }
    }
};
template <bool RB>
struct EpiResid {
    static constexpr bool PERM = true, AFTER_DRAIN = false;
    static constexpr int MB = RB ? 4 : 2;
    const float* resid; bf16_t* XB; float* ss_out; int ldc;
    __device__ __forceinline__ void operator()(const f32x4 (&acc)[2][2][4][2], const Unit& u, int wr, int wc, int fr, int fq) const {
        const int row0 = u.pm * BM + wr * 64 + fr, col0 = u.pn * BM + wc * 32 + 8 * fq;
#pragma unroll
        for (int ai = 0; ai < 2; ++ai)
#pragma unroll
          for (int mb = 0; mb < 4; mb += MB) {
            u32x4 rb[MB][2]; f32x4 rf[RB ? 1 : MB][2][2];
#pragma unroll
            for (int mm = 0; mm < MB; ++mm) { const size_t off = (size_t)(row0 + ai * HALF + (mb + mm) * 16) * ldc + col0;
#pragma unroll
                for (int bj = 0; bj < 2; ++bj) {
                    if constexpr (RB) rb[mm][bj] = *(const u32x4*)(XB + off + bj * HALF);
                    else { rf[mm][bj][0] = *(const f32x4*)(resid + off + bj * HALF); rf[mm][bj][1] = *(const f32x4*)(resid + off + bj * HALF + 4); } } }
#pragma unroll
            for (int mm = 0; mm < MB; ++mm) { const int m = mb + mm, row = row0 + ai * HALF + m * 16; const size_t off = (size_t)row * ldc + col0; float s = 0.f;
#pragma unroll
                for (int bj = 0; bj < 2; ++bj) { f32x4 r0, r1;
                    if constexpr (RB) { const u32x4 q = rb[mm][bj];
                        r0[0] = __builtin_bit_cast(float, q.x << 16); r0[1] = __builtin_bit_cast(float, q.x & 0xffff0000u); r0[2] = __builtin_bit_cast(float, q.y << 16); r0[3] = __builtin_bit_cast(float, q.y & 0xffff0000u);
                        r1[0] = __builtin_bit_cast(float, q.z << 16); r1[1] = __builtin_bit_cast(float, q.z & 0xffff0000u); r1[2] = __builtin_bit_cast(float, q.w << 16); r1[3] = __builtin_bit_cast(float, q.w & 0xffff0000u); }
                    else { r0 = rf[mm][bj][0]; r1 = rf[mm][bj][1]; }
                    const f32x4 v0 = acc[ai][bj][m][0] + r0, v1 = acc[ai][bj][m][1] + r1;
                    u32x4 w; w.x = cvt_pk_bf16(v0[0], v0[1]); w.y = cvt_pk_bf16(v0[2], v0[3]); w.z = cvt_pk_bf16(v1[0], v1[1]); w.w = cvt_pk_bf16(v1[2], v1[3]);
                    *(u32x4*)(XB + off + bj * HALF) = w;
                    s += (v0[0] * v0[0] + v0[1] * v0[1]) + (v0[2] * v0[2] + v0[3] * v0[3]) + (v1[0] * v1[0] + v1[1] * v1[1]) + (v1[2] * v1[2] + v1[3] * v1[3]); }
                s += __shfl_xor(s, 16); s += __shfl_xor(s, 32);
                if (fq == 0) ss_out[((size_t)(u.pm * (ldc / BM) + u.pn) * BM + (row - u.pm * BM)) * 4 + wc] = s; }
            asm volatile("" ::: "memory"); }
    }
};

struct RstdOrder : StaticOrder {
    const float* ssp; const float* ss0; int npn; mutable int cnt; mutable int pmA, pmB;
    static __device__ __forceinline__ PG8_LAS float* tbl() { return (PG8_LAS float*)(unsigned)131072; }
    __device__ __forceinline__ void build(const Unit& u) const {
        const int par = cnt & 1; const bool same = cnt >= 2 && (par ? pmB : pmA) == u.pm; if (par) pmB = u.pm; else pmA = u.pm; ++cnt; const int tid = threadIdx.x;
        if (same) return;
        if (tid < 256) { float s;
            if (ssp) { const char* base = (const char*)(ssp + (size_t)(u.pm * npn) * 1024); int to = tid * 16; asm volatile("" : "+v"(to));
                s = 0.f;
#pragma unroll
                for (int pn = 0; pn < 16; ++pn) { const f32x4 v = *(const f32x4*)(base + (size_t)pn * 4096 + (size_t)(unsigned)to); s += (v[0] + v[1]) + (v[2] + v[3]); } }
            else s = ss0[u.pm * BM + tid];
            tbl()[par * 256 + tid] = rstd_of(s); }
    }
    __device__ __forceinline__ void first_ready(const Unit& u) const { build(u); }
    __device__ __forceinline__ void after_epi(const Unit& u) const { build(u); }
};

template <class Epi, class Sched, bool ALIGN_EPI = false, bool SP2 = false>
__device__ __forceinline__ void gemm_phase(PG8_LAS unsigned char* lds, const Gemm g, const Sched& S, const Epi& E) {
    const int tid = threadIdx.x, wid = __builtin_amdgcn_readfirstlane(tid >> 6), lane = tid & 63, wr = wid >> 2, wc = wid & 3, fr = lane & 15, fq = lane >> 4;
    const int K = g.K, nt = K / BK;
    unsigned voffA[2], voffB[2];
#pragma unroll
    for (int i = 0; i < 2; ++i) { int R, C; stage_rc(tid * 16 + i * 8192, R, C); const int Rb = Epi::PERM ? ((R & ~31) + perm32(R & 31)) : R;
        voffA[i] = (unsigned)(R * K + C) * 2u; voffB[i] = (unsigned)(Rb * K + C) * 2u; }
    const size_t kstep = (size_t)(BK * 2);
    const size_t hstep = (size_t)HALF * K * 2;
    const size_t tstep = 2 * hstep;
    const unsigned ldsw = (unsigned)wid * 1024u;
    const int aoff = lds_byte(wr * 64 + fr, fq * 8), boff = lds_byte(wc * 32 + fr, fq * 8);
#define PG8_SA(b, h) (((b) * 2 + (h)) * HTB)
#define PG8_SB(b, h) ((4 + (b) * 2 + (h)) * HTB)
#define PG8_STAGE(bufoff, gbase, voff) do { _Pragma("unroll") for (int _i = 0; _i < 2; ++_i) \
        __builtin_amdgcn_global_load_lds((const unsigned*)((const char*)(gbase) + (voff)[_i]), (PG8_LAS unsigned*)(lds + (bufoff) + ldsw + _i * 8192), 16, 0, 0); } while (0)
#define PG8_LDA(dst, b, h) do { _Pragma("unroll") for (int m = 0; m < 4; ++m) _Pragma("unroll") for (int k = 0; k < 2; ++k) dst[m][k] = *(const PG8_LAS bf16x8*)(lds + PG8_SA(b, h) + aoff + m * 2048 + k * 1024); } while (0)
#define PG8_LDB(dst, b, h) do { _Pragma("unroll") for (int n = 0; n < 2; ++n) _Pragma("unroll") for (int k = 0; k < 2; ++k) dst[n][k] = *(const PG8_LAS bf16x8*)(lds + PG8_SB(b, h) + boff + n * 2048 + k * 1024); } while (0)
#define PG8_MMA(ai, bj, At, Bt) do { __builtin_amdgcn_s_setprio(1); _Pragma("unroll") for (int m = 0; m < 4; ++m) _Pragma("unroll") for (int n = 0; n < 2; ++n) _Pragma("unroll") for (int k = 0; k < 2; ++k) \
        acc[ai][bj][m][n] = __builtin_amdgcn_mfma_f32_16x16x32_bf16(Bt[n][k], At[m][k], acc[ai][bj][m][n], 0, 0, 0); __builtin_amdgcn_s_setprio(0); } while (0)
#define PG8_WAIT_V(n) asm volatile("s_waitcnt vmcnt(" #n ")" ::: "memory")
#define PG8_WAIT_L(n) asm volatile("s_waitcnt lgkmcnt(" #n ")" ::: "memory")
#define PG8_BAR __builtin_amdgcn_s_barrier()
#define PG8_SCHED __builtin_amdgcn_sched_barrier(0)
    Unit cur, nxt; int ui = 0;
    if (!S.next(0, cur)) return;
    f32x4 acc[2][2][4][2];
#pragma unroll
    for (int a = 0; a < 2; ++a)
#pragma unroll
        for (int b = 0; b < 2; ++b)
#pragma unroll
            for (int m = 0; m < 4; ++m)
#pragma unroll
                for (int n = 0; n < 2; ++n) acc[a][b][m][n] = (f32x4){0.f, 0.f, 0.f, 0.f};
    bf16x8 At[4][2], B0[2][2], B1[2][2];
    const char* cA = (const char*)g.A + (size_t)cur.pm * tstep; const char* cB = (const char*)g.Bt + (size_t)cur.pn * tstep;
    S.first_ready(cur);
    if constexpr (SP2) {
        PG8_STAGE(PG8_SB(0, 0), cB, voffB); PG8_STAGE(PG8_SB(0, 1), cB + hstep, voffB); PG8_STAGE(PG8_SA(0, 0), cA, voffA); PG8_STAGE(PG8_SA(0, 1), cA + hstep, voffA);
        if (wr == 1) PG8_BAR;
        PG8_WAIT_V(2); PG8_BAR;
        PG8_STAGE(PG8_SB(1, 0), cB + kstep, voffB); PG8_STAGE(PG8_SA(1, 0), cA + kstep, voffA); PG8_STAGE(PG8_SB(1, 1), cB + hstep + kstep, voffB);
        PG8_WAIT_V(6); PG8_BAR;
    } else {
        PG8_STAGE(PG8_SB(0, 0), cB, voffB); PG8_STAGE(PG8_SA(0, 0), cA, voffA); PG8_STAGE(PG8_SB(0, 1), cB + hstep, voffB); PG8_STAGE(PG8_SA(0, 1), cA + hstep, voffA);
        if (wr == 1) PG8_BAR;
        PG8_WAIT_V(4); PG8_BAR;
        PG8_STAGE(PG8_SB(1, 0), cB + kstep, voffB); PG8_STAGE(PG8_SA(1, 0), cA + kstep, voffA); PG8_STAGE(PG8_SB(1, 1), cB + hstep + kstep, voffB);
        PG8_WAIT_V(6); PG8_BAR;
    }
    for (;;) {
        const bool has_next = S.next(ui + 1, nxt);
        const char* nA = has_next ? (const char*)g.A + (size_t)nxt.pm * tstep : cA; const char* nB = has_next ? (const char*)g.Bt + (size_t)nxt.pn * tstep : cB;
        for (int t = 0; t < nt; t += 2) {
            const bool last = (t == nt - 2);
            const char* a1 = cA + (size_t)(t + 1) * kstep;
            const char* a2 = last ? nA : cA + (size_t)(t + 2) * kstep; const char* b2 = last ? nB : cB + (size_t)(t + 2) * kstep;
            const char* a3 = a2 + kstep; const char* b3 = b2 + kstep;
            if (last && has_next) S.a_ready(nxt);
            if constexpr (SP2) {
            PG8_LDB(B0, 0, 0); PG8_LDB(B1, 0, 1); PG8_SCHED; PG8_LDA(At, 0, 0); PG8_STAGE(PG8_SA(1, 1), a1 + hstep, voffA);
            PG8_WAIT_V(8); PG8_WAIT_L(0); PG8_BAR; PG8_MMA(0, 0, At, B0); PG8_MMA(0, 1, At, B1); PG8_BAR; PG8_SCHED;
            PG8_LDA(At, 0, 1); PG8_STAGE(PG8_SB(0, 0), b2, voffB); PG8_STAGE(PG8_SB(0, 1), b2 + hstep, voffB); PG8_STAGE(PG8_SA(0, 0), a2, voffA);
            PG8_WAIT_V(8); PG8_WAIT_L(0); PG8_BAR; PG8_MMA(1, 0, At, B0); PG8_MMA(1, 1, At, B1); PG8_BAR; PG8_SCHED;
            PG8_LDB(B0, 1, 0); PG8_LDB(B1, 1, 1); PG8_SCHED; PG8_LDA(At, 1, 0); PG8_STAGE(PG8_SA(0, 1), a2 + hstep, voffA);
            PG8_WAIT_V(8); PG8_WAIT_L(0); PG8_BAR; PG8_MMA(0, 0, At, B0); PG8_MMA(0, 1, At, B1); PG8_BAR; PG8_SCHED;
            PG8_LDA(At, 1, 1); PG8_STAGE(PG8_SB(1, 0), b3, voffB); PG8_STAGE(PG8_SB(1, 1), b3 + hstep, voffB); PG8_STAGE(PG8_SA(1, 0), a3, voffA);
            PG8_WAIT_V(8); PG8_WAIT_L(0); PG8_BAR; PG8_MMA(1, 0, At, B0); PG8_MMA(1, 1, At, B1); PG8_BAR; PG8_SCHED;
            } else {
            PG8_LDB(B0, 0, 0); PG8_SCHED; PG8_LDA(At, 0, 0); PG8_STAGE(PG8_SA(1, 1), a1 + hstep, voffA);
            PG8_WAIT_L(8); PG8_BAR; PG8_WAIT_L(0); PG8_MMA(0, 0, At, B0); PG8_BAR; PG8_SCHED;
            PG8_LDB(B1, 0, 1); PG8_STAGE(PG8_SB(0, 0), b2, voffB);
            PG8_BAR; PG8_WAIT_L(0); PG8_MMA(0, 1, At, B1); PG8_BAR;
            PG8_LDA(At, 0, 1); PG8_STAGE(PG8_SA(0, 0), a2, voffA);
            PG8_BAR; PG8_WAIT_L(0); PG8_MMA(1, 0, At, B0); PG8_BAR; PG8_SCHED;
            PG8_STAGE(PG8_SB(0, 1), b2 + hstep, voffB);
            PG8_WAIT_V(6); PG8_BAR; PG8_MMA(1, 1, At, B1); PG8_BAR;
            PG8_LDB(B0, 1, 0); PG8_SCHED; PG8_LDA(At, 1, 0); PG8_STAGE(PG8_SA(0, 1), a2 + hstep, voffA);
            PG8_WAIT_L(8); PG8_BAR; PG8_WAIT_L(0); PG8_MMA(0, 0, At, B0); PG8_BAR; PG8_SCHED;
            PG8_LDB(B1, 1, 1); PG8_STAGE(PG8_SB(1, 0), b3, voffB);
            PG8_BAR; PG8_WAIT_L(0); PG8_MMA(0, 1, At, B1); PG8_BAR;
            PG8_LDA(At, 1, 1); PG8_STAGE(PG8_SA(1, 0), a3, voffA);
            PG8_BAR; PG8_WAIT_L(0); PG8_MMA(1, 0, At, B0); PG8_BAR; PG8_SCHED;
            PG8_STAGE(PG8_SB(1, 1), b3 + hstep, voffB);
            PG8_WAIT_V(6); PG8_BAR; PG8_MMA(1, 1, At, B1); PG8_BAR;
            }
        }
        if constexpr (ALIGN_EPI) { if (wr == 0) PG8_BAR; }
        if constexpr (!Epi::AFTER_DRAIN) { E(acc, cur, wr, wc, fr, fq); S.done(cur); __builtin_amdgcn_sched_barrier(0); if (has_next) S.after_epi(nxt); __builtin_amdgcn_sched_barrier(0); }
        if (!has_next) break;
#pragma unroll
        for (int a = 0; a < 2; ++a)
#pragma unroll
            for (int b = 0; b < 2; ++b)
#pragma unroll
                for (int m = 0; m < 4; ++m)
#pragma unroll
                    for (int n = 0; n < 2; ++n) acc[a][b][m][n] = (f32x4){0.f, 0.f, 0.f, 0.f};
        cur = nxt; cA = nA; cB = nB; ++ui;
        if constexpr (ALIGN_EPI) { if (wr == 1) PG8_BAR; }
    }
    PG8_WAIT_V(0);
    if constexpr (!ALIGN_EPI) { if (wr == 0) PG8_BAR; }
    PG8_BAR;
    if constexpr (Epi::AFTER_DRAIN) { E.fused(acc, cur, wr, wc, fr, fq, lds, wid, lane); S.done(cur); }
#undef PG8_SA
#undef PG8_SB
#undef PG8_STAGE
#undef PG8_LDA
#undef PG8_LDB
#undef PG8_MMA
#undef PG8_WAIT_V
#undef PG8_WAIT_L
#undef PG8_BAR
#undef PG8_SCHED
}
}

constexpr int NWAVES = 8;
constexpr int D = 4096, NB = 4, SEQ = 4096, M = NB * SEQ, NMETA = 16, LTOK = SEQ + NMETA;
constexpr int GH = 4, DK = 512, DV = 1024, QK = 2048, GV = 4096, GR = 16, GIN = 12304, NQKVR = 12288, MGIN = 12320  ;
constexpr int FF = 11008, NGU = 2 * FF;
constexpr float EPS = 1e-6f;
#define DIAG_POISON 0
#define GS_NO_DMA 0
#define GS_C_PACK 0
#ifndef MK_CUTS
#define MK_CUTS 0u
#endif
constexpr int N_PHASES = 14;

constexpr size_t MiB = 1u << 20;
constexpr size_t WS_CTL = 0, CTL_ZERO_BYTES = 2 * MiB;
constexpr size_t WS_WGIN = 2 * MiB;
constexpr size_t WS_WGOUT = 99 * MiB;
constexpr size_t WS_WGU0 = 131 * MiB;
constexpr size_t WS_WDN0 = 303 * MiB;
constexpr size_t WS_WCIN = 389 * MiB;
constexpr size_t WS_WCOUT = 485 * MiB;
constexpr size_t WS_WGU1 = 517 * MiB;
constexpr size_t WS_WDN1 = 689 * MiB;
constexpr size_t WS_XB = 775 * MiB;
constexpr size_t WS_OG = 903 * MiB;
constexpr size_t WS_PROJ = 1031 * MiB;
constexpr size_t WS_O = 1415 * MiB;
constexpr size_t WS_QDF = 1543 * MiB;
constexpr size_t WS_KDNTF = 1607 * MiB;
constexpr size_t WS_ALOW = 1671 * MiB;
constexpr size_t WS_META = 1672 * MiB;
constexpr size_t WS_SC = 1676 * MiB;
constexpr size_t WS_EBL = 1684 * MiB;
constexpr size_t WS_SSP = 1686 * MiB;
constexpr size_t WS_END = 1690 * MiB;
constexpr size_t MT_XB = 0, MT_PROJ = 128 * 1024, MT_O = MT_PROJ + 800 * 1024, MT_OG = MT_O + 256 * 1024, MT_H = MT_OG + 128 * 1024, MT_ACT = MT_H + 256 * 1024, MT_Z = MT_ACT + 352 * 1024,
                 MT_QDF = 2048 * 1024, MT_KDNTF = MT_QDF + 256 * 1024, MT_SC = MT_KDNTF + 256 * 1024, MT_EBL = MT_SC + 32 * 1024;
static_assert(MT_PROJ + (size_t)16 * MGIN * 4 <= MT_O && MT_Z + 2 * 4096 * 4 <= MT_QDF && MT_EBL + 8 * 1024 <= 4 * MiB, "meta map");
constexpr int CW_BAR = 4096;
constexpr int CW_SS = 262144;
constexpr int CW_MSS = CW_SS + 5 * M;
constexpr int MSS_STRIDE = 64;
static_assert((size_t)(CW_MSS + 5 * MSS_STRIDE) * 4 <= CTL_ZERO_BYTES && CW_BAR + N_PHASES * 3456 <= CW_SS, "ctl map");

constexpr int RING_OFF = 0, RING_BYTES = 131072;
constexpr int LDS_BYTES = 163840, LDSCTL_OFF = LDS_BYTES - 1024, MISC_OFF = LDSCTL_OFF + 320;

#define GAS __attribute__((address_space(1)))
#define LAS __attribute__((address_space(3)))
typedef unsigned short bf16;
typedef unsigned v4u __attribute__((ext_vector_type(4)));
typedef unsigned v2u __attribute__((ext_vector_type(2)));
typedef float f32x4 __attribute__((ext_vector_type(4)));
typedef short bf16x8 __attribute__((ext_vector_type(8)));
#define LDS_WAIT() asm volatile("s_waitcnt lgkmcnt(0)" ::: "memory")
#define VM_WAIT() asm volatile("s_waitcnt vmcnt(0)" ::: "memory")
__device__ __forceinline__ unsigned f2bf(float f) { unsigned u = __builtin_bit_cast(unsigned, f); return (u + 0x7fffu + ((u >> 16) & 1u)) >> 16; }
__device__ __forceinline__ unsigned pk2(float lo, float hi) { return f2bf(lo) | (f2bf(hi) << 16); }
__device__ __forceinline__ float bf2f(unsigned short b) { return __builtin_bit_cast(float, (unsigned)b << 16); }
__device__ __forceinline__ float bflo(unsigned w) { return __builtin_bit_cast(float, w << 16); }
__device__ __forceinline__ float bfhi(unsigned w) { return __builtin_bit_cast(float, w & 0xffff0000u); }
__device__ __forceinline__ float wave_sum(float v) {
#pragma unroll
    for (int o = 1; o < 64; o <<= 1) v += __shfl_xor(v, o);
    return v;
}
using pg8::rstd_of; using pg8::silu_f;

#define XB_TMO      128
#define XB_XCNT(j)  (256  + 64 * (j))
#define XB_XSUB(j)  (1280 + 64 * (j))
#define XB_XGEN(j)  (2304 + 64 * (j))
#define XB_TOP      3328
#define XB_TOPGEN   3392
#define XCD_BAR_WORDS 3456
#define XB_SPIN_CAP (1u << 18)

__device__ __forceinline__ unsigned xb_ld(unsigned* p)              { return __hip_atomic_load(p, __ATOMIC_RELAXED, __HIP_MEMORY_SCOPE_AGENT); }
__device__ __forceinline__ unsigned xb_add(unsigned* p, unsigned v) { return __hip_atomic_fetch_add(p, v, __ATOMIC_RELAXED, __HIP_MEMORY_SCOPE_AGENT); }
__device__ __forceinline__ unsigned xb_xcc_id() { return (unsigned)__builtin_amdgcn_s_getreg((3 << 11) | 20) & 0xFu; }
#define XB_SPIN(cond, bar) do { unsigned _sp = 0; while (cond) { __builtin_amdgcn_s_sleep(1); \
    if ((++_sp & 255u) == 0u) { if (xb_ld(&(bar)[XB_TMO])) break; if (_sp > XB_SPIN_CAP) { atomicAdd(&(bar)[XB_TMO], 1u); break; } } } } while (0)

struct XcdBarrier {
    unsigned* bar; unsigned x;
    volatile LAS unsigned* st;
};

__device__ __forceinline__ XcdBarrier xcd_barrier_post(unsigned* bar, volatile LAS unsigned* st) {
    XcdBarrier b; b.bar = bar; b.x = xb_xcc_id(); b.st = st;
    if (threadIdx.x == 0) (void)xb_add(&bar[XB_XCNT(b.x)], 1u);
    return b;
}
__device__ __forceinline__ void xcd_barrier_complete(unsigned* bar, unsigned x, unsigned& nloc, unsigned& nx) {
    const unsigned G = gridDim.x * gridDim.y * gridDim.z;
    unsigned sum, cnt, mine, sp = 0u;
    for (;;) {
        sum = 0u; cnt = 0u; mine = 0u;
#pragma unroll
        for (unsigned j = 0; j < 16; ++j) { const unsigned c = xb_ld(&bar[XB_XCNT(j)]); sum += c; cnt += (c > 0u) ? 1u : 0u; mine = (j == x) ? c : mine; }
        if (sum == G) break;
        __builtin_amdgcn_s_sleep(1);
        if ((++sp & 255u) == 0u) { if (xb_ld(&bar[XB_TMO])) break; if (sp > XB_SPIN_CAP) { atomicAdd(&bar[XB_TMO], 1u); break; } }
    }
    nloc = mine > 0u ? mine : 1u; nx = cnt > 0u ? cnt : 1u;
}

__device__ __forceinline__ void xcd_barrier(const XcdBarrier& b) {
    asm volatile("s_waitcnt vmcnt(0)" ::: "memory");
    __syncthreads();
    if (threadIdx.x == 0) {
        unsigned* bar = b.bar;
        __builtin_amdgcn_s_waitcnt(0);
        unsigned nloc = b.st[0], nx = b.st[1];
        if (nloc == 0u) { xcd_barrier_complete(bar, b.x, nloc, nx); b.st[0] = nloc; b.st[1] = nx; }
        const unsigned old = xb_add(&bar[XB_XSUB(b.x)], 1u);
        const unsigned gen = old / nloc;
        if (old + 1u == (gen + 1u) * nloc) {
            __builtin_amdgcn_fence(__ATOMIC_RELEASE, "agent");
            asm volatile("s_waitcnt vmcnt(0)" ::: "memory");
            const unsigned og = xb_add(&bar[XB_TOP], 1u);
            const unsigned tg = og / nx;
            if (og + 1u == (tg + 1u) * nx) xb_add(&bar[XB_TOPGEN], 1u);
            else XB_SPIN(xb_ld(&bar[XB_TOPGEN]) == tg, bar);
            __builtin_amdgcn_fence(__ATOMIC_ACQUIRE, "agent");
            xb_add(&bar[XB_XGEN(b.x)], 1u);
            asm volatile("s_waitcnt vmcnt(0)" ::: "memory");
        } else {
            XB_SPIN(xb_ld(&bar[XB_XGEN(b.x)]) == gen, bar);
            __builtin_amdgcn_fence(__ATOMIC_ACQUIRE, "agent");
            asm volatile("s_waitcnt vmcnt(0)" ::: "memory");
        }
    }
    __syncthreads();
}

template <int MODE>
__device__ __forceinline__ void cvt_task(const float* __restrict__ W, int K, int ldw, int ncols, const float* __restrict__ gk, bf16* __restrict__ WT, LAS float* scr, int gw, int ngw, int lane) {
    const int nblk = (ncols + 31) / 32, nitems = (K / 64) * nblk, n = lane & 31, hi = lane >> 5, c = lane & 7;
    float v[32];
#define CVT_LOAD(it_) do { const int kb_ = (it_) / nblk, n0_ = ((it_) % nblk) * 32; const bool ok_ = n0_ + n < ncols; const float* wp_ = W + (size_t)(kb_ * 64 + hi) * ldw + n0_ + n; \
        _Pragma("unroll") for (int i = 0; i < 32; ++i) v[i] = ok_ ? wp_[(size_t)(2 * i) * ldw] : 0.f; } while (0)
    int it = gw;
    if (it < nitems) CVT_LOAD(it);
    while (it < nitems) {
        const int kb = it / nblk, n0 = (it % nblk) * 32, k0 = kb * 64; const int ncv = (ncols - n0) < 32 ? (ncols - n0) : 32;
        long dr = n0; if (MODE == 1) dr = (long)(n0 / 128) * 256 + (n0 % 128); if (MODE == 2) dr = (long)(n0 / 128) * 256 + 128 + (n0 % 128);
#pragma unroll
        for (int i = 0; i < 32; ++i) scr[(2 * i + hi) * 33 + n] = v[i];
        f32x4 ga = {1.f, 1.f, 1.f, 1.f}, gb = {1.f, 1.f, 1.f, 1.f};
        if (gk) { ga = *(const f32x4*)(gk + k0 + 8 * c); gb = *(const f32x4*)(gk + k0 + 8 * c + 4); }
        const int nxt = it + ngw;
        if (nxt < nitems) CVT_LOAD(nxt);
        LDS_WAIT(); asm volatile("" ::: "memory");
#pragma unroll
        for (int j = 0; j < 4; ++j) { const int nn = (lane >> 3) + 8 * j; const LAS float* s = scr + (8 * c) * 33 + nn;
            v4u o; o.x = pk2(s[0 * 33] * ga.x, s[1 * 33] * ga.y); o.y = pk2(s[2 * 33] * ga.z, s[3 * 33] * ga.w); o.z = pk2(s[4 * 33] * gb.x, s[5 * 33] * gb.y); o.w = pk2(s[6 * 33] * gb.z, s[7 * 33] * gb.w);
            if (nn < ncv) *(v4u*)(WT + (size_t)(dr + nn) * K + k0 + 8 * c) = o; }
        LDS_WAIT(); asm volatile("" ::: "memory");
        it = nxt;
    }
#undef CVT_LOAD
}
__device__ __forceinline__ void row_to_bf16_ss(const float* xrow, bf16* orow, float* ss, int lane) {
    const f32x4* xr = (const f32x4*)xrow + lane; f32x4 v[16]; float s = 0.f;
#pragma unroll
    for (int j = 0; j < 16; ++j) { v[j] = xr[64 * j]; s += (v[j].x * v[j].x + v[j].y * v[j].y) + (v[j].z * v[j].z + v[j].w * v[j].w); }
    s = wave_sum(s); if (lane == 0) *ss = s;
    v2u* o8 = (v2u*)orow + lane;
#pragma unroll
    for (int j = 0; j < 16; ++j) { v2u w; w.x = pk2(v[j].x, v[j].y); w.y = pk2(v[j].z, v[j].w); o8[64 * j] = w; }
}

template <bool PAIR, class Epi>
__device__ __forceinline__ void thin_gemm16(LAS unsigned char* lds, const bf16* __restrict__ A16, const bf16* __restrict__ Bt, int K, int ntiles, long pair_off, const Epi& epi, int wg, int nwg) {
    const int tid = threadIdx.x, wave = __builtin_amdgcn_readfirstlane(tid >> 6), lane = tid & 63, i = lane & 15, q = lane >> 4;
    LAS float* red = (LAS float*)lds;
    const int nblk = K / 128, kb0 = wave * nblk / 8, kb1 = (wave + 1) * nblk / 8;
    for (int t4 = wg * 4; t4 < ntiles; t4 += nwg * 4)
    for (int t = t4; t < t4 + 4 && t < ntiles; ++t) {
        const long n0 = epi.row0(t);
        const bf16* ap = A16 + (size_t)i * K + 32 * q;
        const bf16* bp = Bt + (size_t)(n0 + i) * K + 32 * q;
        const bf16* bp2 = bp + (size_t)pair_off * K;
        f32x4 acc0 = {0.f, 0.f, 0.f, 0.f}, acc1 = {0.f, 0.f, 0.f, 0.f};
#pragma unroll 2
        for (int kb = kb0; kb < kb1; ++kb) {
            const bf16x8* a = (const bf16x8*)(ap + kb * 128); const bf16x8* b = (const bf16x8*)(bp + kb * 128);
            const bf16x8 a0 = a[0], a1 = a[1], a2 = a[2], a3 = a[3], b0 = b[0], b1 = b[1], b2 = b[2], b3 = b[3];
            acc0 = __builtin_amdgcn_mfma_f32_16x16x32_bf16(a0, b0, acc0, 0, 0, 0); acc0 = __builtin_amdgcn_mfma_f32_16x16x32_bf16(a1, b1, acc0, 0, 0, 0);
            acc0 = __builtin_amdgcn_mfma_f32_16x16x32_bf16(a2, b2, acc0, 0, 0, 0); acc0 = __builtin_amdgcn_mfma_f32_16x16x32_bf16(a3, b3, acc0, 0, 0, 0);
            if (PAIR) { const bf16x8* c = (const bf16x8*)(bp2 + kb * 128); const bf16x8 c0 = c[0], c1 = c[1], c2 = c[2], c3 = c[3];
                acc1 = __builtin_amdgcn_mfma_f32_16x16x32_bf16(a0, c0, acc1, 0, 0, 0); acc1 = __builtin_amdgcn_mfma_f32_16x16x32_bf16(a1, c1, acc1, 0, 0, 0);
                acc1 = __builtin_amdgcn_mfma_f32_16x16x32_bf16(a2, c2, acc1, 0, 0, 0); acc1 = __builtin_amdgcn_mfma_f32_16x16x32_bf16(a3, c3, acc1, 0, 0, 0); }
        }
#pragma unroll
        for (int j = 0; j < 4; ++j) { red[((wave * 2 + 0) * 4 + j) * 64 + lane] = acc0[j]; if (PAIR) red[((wave * 2 + 1) * 4 + j) * 64 + lane] = acc1[j]; }
        __syncthreads();
        if (tid < 256) { const int l = tid & 63, j = tid >> 6; float v0 = 0.f, v1 = 0.f;
#pragma unroll
            for (int w = 0; w < 8; ++w) { v0 += red[((w * 2 + 0) * 4 + j) * 64 + l]; if (PAIR) v1 += red[((w * 2 + 1) * 4 + j) * 64 + l]; }
            epi(t, 4 * (l >> 4) + j, l & 15, v0, v1); }
        __syncthreads();
    }
}


__device__ __forceinline__ void thin_row_rstd(LAS float* tbl, const float* __restrict__ X) {
    const int tid = threadIdx.x, r = tid >> 5, l = tid & 31; const f32x4* xr = (const f32x4*)(X + (size_t)r * D) + l; float s = 0.f;
#pragma unroll 8
    for (int j = 0; j < 32; ++j) { const f32x4 v = xr[32 * j]; s += (v.x * v.x + v.y * v.y) + (v.z * v.z + v.w * v.w); }
    s += __shfl_xor(s, 1); s += __shfl_xor(s, 2); s += __shfl_xor(s, 4); s += __shfl_xor(s, 8); s += __shfl_xor(s, 16);
    if (l == 0) tbl[r] = rstd_of(s);
    __syncthreads();
}

struct TE_ALow {
    float* alow; const float* ss;
    __device__ __forceinline__ long row0(int t) const { return (long)t * 16; }
    __device__ __forceinline__ void operator()(int t, int r, int c, float v0, float) const { const int tok = t * 16 + c; alow[(size_t)tok * 16 + r] = v0 * rstd_of(ss[tok]); }
};
struct TE_MProj {
    float* mproj; const LAS float* rs;
    __device__ __forceinline__ long row0(int t) const { return (long)t * 16; }
    __device__ __forceinline__ void operator()(int t, int r, int c, float v0, float) const { mproj[(size_t)r * MGIN + t * 16 + c] = v0 * rs[r]; }
};
struct TE_MResid {
    const float* resid; float* mh; bf16* mxb; float* mss_out;
    __device__ __forceinline__ long row0(int t) const { return (long)t * 16; }
    __device__ __forceinline__ void operator()(int t, int r, int c, float v0, float) const {
        const size_t o = (size_t)r * D + t * 16 + c; const float h = resid[o] + v0; mh[o] = h; mxb[o] = (bf16)f2bf(h);
        (void)mss_out;
    }
};
struct TE_MSwiGLU {
    bf16* mact; const LAS float* rs;
    __device__ __forceinline__ long row0(int t) const { return (long)(t >> 3) * 256 + (t & 7) * 16; }
    __device__ __forceinline__ void operator()(int t, int r, int c, float v0, float v1) const { const float sc = rs[r];
        mact[(size_t)r * FF + (t >> 3) * 128 + (t & 7) * 16 + c] = (bf16)f2bf(silu_f(v0 * sc) * (v1 * sc)); }
};
struct TE_MConvZ {
    float* zm; const LAS float* rs;
    __device__ __forceinline__ long row0(int t) const { return 4096 + (long)(t >> 3) * 256 + (t & 7) * 16; }
    __device__ __forceinline__ void operator()(int t, int r, int c, float v0, float v1) const { const float sc = rs[r];
        if (r >= 14) zm[(size_t)(r - 14) * D + t * 16 + c] = (v0 * sc) * (v1 * sc); }
};

typedef float f32x16 __attribute__((ext_vector_type(16)));
#define MFMA32(a, b, c) __builtin_amdgcn_mfma_f32_32x32x16_bf16((a), (b), (c), 0, 0, 0)
constexpr int GP_LD = 1040;
constexpr int GP_QD = 0, GP_KDN = 64 * GP_LD, GP_AL = 2 * 64 * GP_LD;
constexpr int GS_KT = 0, GS_OP = 65536, GS_VT = 131072, GS_VT_LD = 144, GS_EB = GS_VT + 64 * GS_VT_LD;
constexpr int GLA_ITEM_FR = 64 * 512;
__device__ __forceinline__ bf16x8 pack_step(const f32x16& x, int s) {
    v4u p;
#if GS_C_PACK
    if (s == 0) { p[0] = pk2(x[0], x[1]); p[1] = pk2(x[2], x[3]); p[2] = pk2(x[4], x[5]); p[3] = pk2(x[6], x[7]); }
    else { p[0] = pk2(x[8], x[9]); p[1] = pk2(x[10], x[11]); p[2] = pk2(x[12], x[13]); p[3] = pk2(x[14], x[15]); }
    return __builtin_bit_cast(bf16x8, p);
#endif
    if (s == 0) asm volatile("v_cvt_pk_bf16_f32 %0, %4, %5\n\tv_cvt_pk_bf16_f32 %1, %6, %7\n\tv_cvt_pk_bf16_f32 %2, %8, %9\n\tv_cvt_pk_bf16_f32 %3, %10, %11\n\ts_nop 1"
               : "=&v"(p[0]), "=&v"(p[1]), "=&v"(p[2]), "=&v"(p[3]) : "v"(x[0]), "v"(x[1]), "v"(x[2]), "v"(x[3]), "v"(x[4]), "v"(x[5]), "v"(x[6]), "v"(x[7]));
    else asm volatile("v_cvt_pk_bf16_f32 %0, %4, %5\n\tv_cvt_pk_bf16_f32 %1, %6, %7\n\tv_cvt_pk_bf16_f32 %2, %8, %9\n\tv_cvt_pk_bf16_f32 %3, %10, %11\n\ts_nop 1"
               : "=&v"(p[0]), "=&v"(p[1]), "=&v"(p[2]), "=&v"(p[3]) : "v"(x[8]), "v"(x[9]), "v"(x[10]), "v"(x[11]), "v"(x[12]), "v"(x[13]), "v"(x[14]), "v"(x[15]));
    return __builtin_bit_cast(bf16x8, p);
}
__device__ __forceinline__ void gla_prep_item(LAS unsigned char* sm, bool meta, const bf16* __restrict__ prow  , const float* __restrict__ arow  ,
                                              const float* __restrict__ MPROJ, int h, const float* __restrict__ w_a2, const float* __restrict__ b_a,
                                              bf16* __restrict__ qdf, bf16* __restrict__ kdntf, bf16* __restrict__ sc, float* __restrict__ ebl) {
    const int tid = threadIdx.x, wave = __builtin_amdgcn_readfirstlane(tid >> 6), lane = tid & 63, k = tid, kcol = h * DK + k;
    LAS float* AL = (LAS float*)(sm + GP_AL);
    if (tid < 256) { f32x4 a4 = {0.f, 0.f, 0.f, 0.f};
        if (!meta) a4 = *((const f32x4*)arow + tid);
        else { const int t = tid >> 2; if (t >= 48) a4 = *((const f32x4*)(MPROJ + (size_t)(t - 48) * MGIN + NQKVR) + (tid & 3)); }
        *((LAS f32x4*)AL + tid) = a4; }
    float w[16];
#pragma unroll
    for (int r = 0; r < 16; ++r) w[r] = w_a2[r * QK + kcol];
    const float ba = b_a[kcol];
    __syncthreads();
    float bc = 0.f;
    for (int g8 = 0; g8 < 8; ++g8) {
        float qv[8], kv[8];
#pragma unroll
        for (int e = 0; e < 8; ++e) { const int t = g8 * 8 + e;
            if (!meta) { qv[e] = bf2f(prow[(size_t)t * NQKVR + kcol]); kv[e] = bf2f(prow[(size_t)t * NQKVR + QK + kcol]); }
            else if (t >= 48) { qv[e] = MPROJ[(size_t)(t - 48) * MGIN + kcol]; kv[e] = MPROJ[(size_t)(t - 48) * MGIN + QK + kcol]; }
            else { qv[e] = 0.f; kv[e] = 0.f; } }
        unsigned kp[4];
#pragma unroll
        for (int e = 0; e < 8; ++e) { const int t = g8 * 8 + e;
            if (!meta || t >= 48) {
                float x = ba;
#pragma unroll
                for (int r4 = 0; r4 < 4; ++r4) { const f32x4 a4 = *((const LAS f32x4*)AL + t * 4 + r4); x += a4.x * w[4 * r4] + a4.y * w[4 * r4 + 1] + a4.z * w[4 * r4 + 2] + a4.w * w[4 * r4 + 3]; }
                const float ls = fminf(x, 0.f) - __logf(1.0f + __expf(-fabsf(x)));
                bc += ls * (1.0f / 16.0f); }
            const float eb = __expf(bc), en = 1.0f / eb;
            const unsigned qd = f2bf(qv[e] * eb * 0.04419417382415922f), kd = f2bf(kv[e] * en);
            *(LAS unsigned short*)(sm + GP_QD + t * GP_LD + k * 2) = (unsigned short)qd;
            *(LAS unsigned short*)(sm + GP_KDN + t * GP_LD + k * 2) = (unsigned short)kd;
            if (e & 1) kp[e >> 1] |= kd << 16; else kp[e >> 1] = kd; }
        { v4u o; o.x = kp[0]; o.y = kp[1]; o.z = kp[2]; o.w = kp[3];
          *(v4u*)(kdntf + ((size_t)(((k >> 5) * 4 + (g8 >> 1)) * 64 + (k & 31) + 32 * (g8 & 1))) * 8) = o; }
    }
    ebl[k] = __expf(bc);
    __syncthreads();
    const int r = lane & 31, hh = lane >> 5;
    if (wave < 4) {
        const int ti = wave & 1, tj = wave >> 1;
        f32x16 acc;
#pragma unroll
        for (int i = 0; i < 16; ++i) acc[i] = 0.f;
        const LAS unsigned char* pa = sm + GP_QD + (32 * ti + r) * GP_LD + 16 * hh; const LAS unsigned char* pb = sm + GP_KDN + (32 * tj + r) * GP_LD + 16 * hh;
#pragma unroll 8
        for (int kb = 0; kb < 32; ++kb) { const bf16x8 a = *(const LAS bf16x8*)(pa + kb * 32), b = *(const LAS bf16x8*)(pb + kb * 32); acc = MFMA32(a, b, acc); }
#pragma unroll
        for (int i = 0; i < 16; ++i) { const int ii = 32 * ti + (i & 3) + 8 * (i >> 2) + 4 * hh, jj = 32 * tj + r; sc[ii * 64 + jj] = (bf16)f2bf(jj <= ii ? acc[i] : 0.f); }
    } else {
        const int t2 = tid - 256;
#pragma unroll 4
        for (int n = 0; n < 16; ++n) { const int pi = t2 + 256 * n, f = pi >> 6, l = pi & 63, rr = l & 31, h2 = l >> 5, kt = f >> 2, s = (f >> 1) & 1, tt = f & 1;
            const LAS unsigned char* src = sm + GP_QD + (32 * tt + rr) * GP_LD + (32 * kt + 16 * s + 4 * h2) * 2;
            const v2u lo = *(const LAS v2u*)src, hi = *(const LAS v2u*)(src + 16);
            v4u o; o.x = lo.x; o.y = lo.y; o.z = hi.x; o.w = hi.y;
            *(v4u*)(qdf + (size_t)pi * 8) = o; }
    }
    __syncthreads();
}
__device__ __forceinline__ void gla_scan(LAS unsigned char* sm, const bf16* __restrict__ PROJ, const float* __restrict__ MPROJ, const bf16* __restrict__ QDF, const bf16* __restrict__ KDNTF, const bf16* __restrict__ SC,
                                         const float* __restrict__ EBL, const bf16* __restrict__ MQDF, const bf16* __restrict__ MKDNTF, const bf16* __restrict__ MSC, const float* __restrict__ MEBL,
                                         bf16* __restrict__ O, float* __restrict__ MO) {
    const int tid = threadIdx.x, wave = __builtin_amdgcn_readfirstlane(tid >> 6), lane = tid & 63, r = lane & 31, hh = lane >> 5, half = wave >> 2, js = wave & 3;
    const int sa_off = (r * 64 + 16 * js + 8 * hh) * 2;
    const int vt_ = lane, v8_ = wave * 8;
    const LAS unsigned char* vb0 = sm + GS_VT + (32 * half + r) * GS_VT_LD + 16 * hh;
    const LAS unsigned char* vb1 = sm + GS_VT + (32 * (half ^ 1) + r) * GS_VT_LD + 16 * hh;
    const LAS unsigned char* eb_rd = sm + GS_EB + (64 * wave + 4 * hh) * 4;
    LAS unsigned char* op_wr = sm + wave * 16384 + lane * 4;
    const int op_y0 = half * 4096, op_y1 = (half ^ 1) * 4096;
    const LAS unsigned char* op_rd = sm + (tid >> 4) * 256 + (tid & 15) * 16;
    const int red_t = 8 * ((tid >> 6) & 3) + 4 * ((tid >> 3) & 1) + ((tid >> 4) & 3), red_v = 32 * ((tid >> 8) & 1) + 4 * (tid & 7);
    for (int u0 = blockIdx.x; u0 < 256; u0 += gridDim.x) {
        const int u = gridDim.x == 256 ? ((u0 & 7) * 2 + (u0 >> 7)) * 16 + ((u0 >> 3) & 15) : u0;
        const int b = u >> 6, h = (u >> 4) & 3, vs = u & 15;
        f32x16 S00, S01, S10, S11;
#pragma unroll
        for (int i = 0; i < 16; ++i) { S00[i] = 0.f; S01[i] = 0.f; S10[i] = 0.f; S11[i] = 0.f; }
        bf16x8 qa[8], ka[8], sa[2]; v4u vreg; f32x4 ereg = {0.f, 0.f, 0.f, 0.f};
        const char* const mqf = (const char*)(MQDF + (size_t)h * GLA_ITEM_FR); const char* const mkf = (const char*)(MKDNTF + (size_t)h * GLA_ITEM_FR);
        const char* const msc = (const char*)(MSC + (size_t)h * 4096); const float* const meb = MEBL + h * DK;
#define GS_ITEM(c) const size_t it_ = ((size_t)b * 64 + (size_t)((c) > 0 ? (c) - 1 : 0)) * GH + h; \
            const char* qf_ = (c) == 0 ? mqf : (const char*)(QDF + it_ * GLA_ITEM_FR); const char* kf_ = (c) == 0 ? mkf : (const char*)(KDNTF + it_ * GLA_ITEM_FR); \
            const char* sc_ = (c) == 0 ? msc : (const char*)(SC + it_ * 4096); const float* eb_ = (c) == 0 ? meb : EBL + it_ * DK; (void)qf_; (void)kf_; (void)sc_; (void)eb_
#define GS_OPQ(name, val) int name##_i = (val); asm volatile("" : "+v"(name##_i)); const size_t name = (size_t)(unsigned)name##_i
#define GS_LOAD_Q(c) do { GS_ITEM(c); const char* qb_ = qf_ + wave * 8192; GS_OPQ(l16_, lane * 16); GS_OPQ(sao_, (int)sa_off); \
            _Pragma("unroll") for (int f = 0; f < 8; ++f) qa[f] = *(const bf16x8*)(qb_ + f * 1024 + l16_); \
            sa[0] = *(const bf16x8*)(sc_ + sao_); sa[1] = *(const bf16x8*)(sc_ + 4096 + sao_); } while (0)
#define GS_LOAD_K(c) do { GS_ITEM(c); const char* kb_ = kf_ + wave * 8192; GS_OPQ(l16_, lane * 16); \
            _Pragma("unroll") for (int j = 0; j < 8; ++j) ka[j] = *(const bf16x8*)(kb_ + j * 1024 + l16_); } while (0)
#define GS_LOAD_V(c) do { GS_ITEM(c); \
            if (tid < 128) { GS_OPQ(eo_, tid * 16); ereg = *(const f32x4*)((const char*)eb_ + eo_); } \
            if ((c) == 0) { if (vt_ >= 48) { GS_OPQ(vo_, ((vt_ - 48) * MGIN + v8_) * 4); const float* vp = (const float*)((const char*)(MPROJ + 2 * QK + h * DV + vs * 64) + vo_); const f32x4 x0 = *(const f32x4*)vp, x1 = *(const f32x4*)(vp + 4); \
                                  vreg.x = pk2(x0.x, x0.y); vreg.y = pk2(x0.z, x0.w); vreg.z = pk2(x1.x, x1.y); vreg.w = pk2(x1.z, x1.w); } else { vreg = (v4u){0u, 0u, 0u, 0u}; } } \
            else { GS_OPQ(vo_, (vt_ * NQKVR + v8_) * 2); vreg = *(const v4u*)((const char*)(PROJ + ((size_t)b * SEQ + (size_t)(((c) - 1) * 64)) * NQKVR + 2 * QK + h * DV + vs * 64) + vo_); } } while (0)
#define GS_STEP1() do { _Pragma("unroll") for (int e = 0; e < 8; ++e) { const unsigned wv = vreg[e >> 1]; *(LAS unsigned short*)(sm + GS_VT + (v8_ + e) * GS_VT_LD + vt_ * 2) = (unsigned short)((e & 1) ? (wv >> 16) : (wv & 0xffffu)); } \
            if (tid < 128) *((LAS f32x4*)(sm + GS_EB) + tid) = ereg; } while (0)
        GS_LOAD_V(0); GS_LOAD_Q(0);
        GS_STEP1();
#pragma unroll 1
        for (int c = 0; c <= 64; ++c) {
            __syncthreads();
            GS_LOAD_K(c);
            if (c < 64) GS_LOAD_V(c + 1);
            __builtin_amdgcn_sched_barrier(0);
#define GS_OHALF(Sa, Sb, vbp, sfrag, tsel, opy) do { f32x16 o0, o1; _Pragma("unroll") for (int i = 0; i < 16; ++i) { o0[i] = 0.f; o1[i] = 0.f; } \
              _Pragma("unroll") for (int s = 0; s < 2; ++s) { const bf16x8 sb = pack_step(Sa, s); o0 = MFMA32(qa[s * 2 + 0], sb, o0); o1 = MFMA32(qa[s * 2 + 1], sb, o1); } \
              _Pragma("unroll") for (int s = 0; s < 2; ++s) { const bf16x8 sb = pack_step(Sb, s); o0 = MFMA32(qa[4 + s * 2 + 0], sb, o0); o1 = MFMA32(qa[4 + s * 2 + 1], sb, o1); } \
              { const bf16x8 vI = *(const LAS bf16x8*)((vbp) + js * 32); if (tsel == 0) o0 = MFMA32(sfrag, vI, o0); else o1 = MFMA32(sfrag, vI, o1); } \
              _Pragma("unroll") for (int i = 0; i < 16; ++i) { *(LAS float*)(op_wr + (opy) + i * 256) = o0[i]; *(LAS float*)(op_wr + 8192 + (opy) + i * 256) = o1[i]; } \
              __builtin_amdgcn_sched_barrier(0); } while (0)
            GS_OHALF(S00, S10, vb0, sa[0], 0, op_y0);
            GS_OHALF(S01, S11, vb1, sa[1], 1, op_y1);
            {
              bf16x8 vB0[4], vB1[4];
#pragma unroll
              for (int ts = 0; ts < 4; ++ts) { vB0[ts] = *(const LAS bf16x8*)(vb0 + ts * 32); vB1[ts] = *(const LAS bf16x8*)(vb1 + ts * 32); }
              f32x4 ea[4], ec[4];
#define GS_EBLD(e, kt) do { _Pragma("unroll") for (int g4 = 0; g4 < 4; ++g4) e[g4] = *(const LAS f32x4*)(eb_rd + (32 * (kt) + 8 * g4) * 4); } while (0)
#define GS_EBMUL(Sx, e) do { _Pragma("unroll") for (int g4 = 0; g4 < 4; ++g4) { Sx[4 * g4 + 0] *= e[g4].x; Sx[4 * g4 + 1] *= e[g4].y; Sx[4 * g4 + 2] *= e[g4].z; Sx[4 * g4 + 3] *= e[g4].w; } \
                asm volatile("" : "+v"(Sx));     } while (0)
              GS_EBLD(ea, 0); GS_EBLD(ec, 1);
#pragma unroll
              for (int ts = 0; ts < 4; ++ts) {
                S00 = MFMA32(ka[ts], vB0[ts], S00); S01 = MFMA32(ka[ts], vB1[ts], S01); S10 = MFMA32(ka[4 + ts], vB0[ts], S10); S11 = MFMA32(ka[4 + ts], vB1[ts], S11); }
              __builtin_amdgcn_sched_barrier(0);
              if (c < 64) GS_LOAD_Q(c + 1);
              __builtin_amdgcn_sched_barrier(0);
              GS_EBMUL(S00, ea); GS_EBMUL(S01, ea); __builtin_amdgcn_sched_barrier(0);
              GS_EBMUL(S10, ec); GS_EBMUL(S11, ec); __builtin_amdgcn_sched_barrier(0);
#undef GS_EBLD
#undef GS_EBMUL
            }
            __syncthreads();
            if (c < 64) GS_STEP1();
            { int lo = (red_t * GV + red_v) * 2; asm volatile("" : "+v"(lo));
              const char* const ob = (const char*)(O + ((size_t)b * SEQ + (size_t)((c > 0 ? c - 1 : 0) * 64)) * GV + h * DV + vs * 64);
#pragma unroll
              for (int p = 0; p < 2; ++p) {
                f32x4 s4 = *(const LAS f32x4*)(op_rd + p * 8192);
#pragma unroll
                for (int w8 = 1; w8 < 8; ++w8) { const f32x4 x = *(const LAS f32x4*)(op_rd + w8 * 16384 + p * 8192); s4.x += x.x; s4.y += x.y; s4.z += x.z; s4.w += x.w; }
                if (p == 1 && c == 0 && b == 0 && red_t >= 16) *(f32x4*)(MO + (size_t)(red_t - 16) * GV + h * DV + vs * 64 + red_v) = s4;
                { v2u w; w.x = pk2(s4.x, s4.y); w.y = pk2(s4.z, s4.w); *(v2u*)(ob + (size_t)p * (32 * GV * 2) + lo) = w; } } }
            __builtin_amdgcn_sched_barrier(0);
        }
#undef GS_ITEM
#undef GS_LOAD_Q
#undef GS_LOAD_K
#undef GS_LOAD_V
#undef GS_OPQ
#undef GS_OHALF
#undef GS_STEP1
        __syncthreads();
    }
}

template <bool OBF>
__device__ __forceinline__ void gate_item(const void* orow  , const float* __restrict__ hn, f32x4 (&rv)[4], bf16* og, int lane) {
    f32x4 v[4]; float s = 0.f;
#pragma unroll
    for (int j = 0; j < 4; ++j) {
        if (OBF) { const v2u w = *((const v2u*)orow + lane + 64 * j); v[j] = (f32x4){bflo(w.x), bfhi(w.x), bflo(w.y), bfhi(w.y)}; }
        else v[j] = *((const f32x4*)orow + lane + 64 * j);
        s += (v[j].x * v[j].x + v[j].y * v[j].y) + (v[j].z * v[j].z + v[j].w * v[j].w); }
    const float rs = 1.0f / sqrtf(wave_sum(s) * (1.0f / DV) + EPS);
#pragma unroll
    for (int j = 0; j < 4; ++j) { const f32x4 g = *((const f32x4*)hn + lane + 64 * j);
        v2u w; w.x = pk2(v[j].x * rs * g.x * silu_f(rv[j].x), v[j].y * rs * g.y * silu_f(rv[j].y)); w.y = pk2(v[j].z * rs * g.z * silu_f(rv[j].z), v[j].w * rs * g.w * silu_f(rv[j].w));
        *((v2u*)og + lane + 64 * j) = w; }
}

struct Args { const float* in[16]; float* out; unsigned char* ws; int ph_lo, ph_hi, li, pad; };
enum { I_X = 0, I_META, I_NMIX, I_NFFN, I_GWIN, I_GWA2, I_GBA, I_GHN, I_GWOUT, I_CWIN, I_CW, I_CWOUT, I_FGATE, I_FUP, I_FDOWN, I_NFINAL };

__global__ void __launch_bounds__(NWAVES * 64, 2) trunk_fwd(Args args) {
    extern __shared__ __attribute__((aligned(16))) unsigned char lds_raw[];
    LAS unsigned char* lds = (LAS unsigned char*)lds_raw;
    volatile LAS unsigned* MISC = (volatile LAS unsigned*)(lds + MISC_OFF);
    const int tid = threadIdx.x, lane = tid & 63, wave = __builtin_amdgcn_readfirstlane(tid >> 6);
    const int G = gridDim.x, bx = blockIdx.x;
    const int gw = bx * NWAVES + wave, NGW = G * NWAVES;
    unsigned char* ws = args.ws;
    unsigned* ctl = (unsigned*)(ws + WS_CTL);
    float* SS = (float*)ctl + CW_SS; float* MSS = (float*)ctl + CW_MSS; float* SSP = (float*)(ws + WS_SSP); constexpr size_t SSP_N = (size_t)64 * 16 * 256 * 4;
    const float* x = args.in[I_X]; float* out = args.out;
    bf16* W_GIN = (bf16*)(ws + WS_WGIN); bf16* W_GOUT = (bf16*)(ws + WS_WGOUT); bf16* W_GU0 = (bf16*)(ws + WS_WGU0); bf16* W_DN0 = (bf16*)(ws + WS_WDN0);
    bf16* W_CIN = (bf16*)(ws + WS_WCIN); bf16* W_COUT = (bf16*)(ws + WS_WCOUT); bf16* W_GU1 = (bf16*)(ws + WS_WGU1); bf16* W_DN1 = (bf16*)(ws + WS_WDN1);
    bf16* XB = (bf16*)(ws + WS_XB); bf16* OG = (bf16*)(ws + WS_OG); bf16* PROJ = (bf16*)(ws + WS_PROJ); bf16* ACT = PROJ; bf16* CBG = PROJ; bf16* CZ = PROJ + (size_t)M * D;
    bf16* O = (bf16*)(ws + WS_O); float* ALOW = (float*)(ws + WS_ALOW);
    bf16* QDF = (bf16*)(ws + WS_QDF); bf16* KDNTF = (bf16*)(ws + WS_KDNTF); bf16* SC = (bf16*)(ws + WS_SC); float* EBL = (float*)(ws + WS_EBL);
    unsigned char* mt = ws + WS_META;
    bf16* MXB = (bf16*)(mt + MT_XB); float* MPROJ = (float*)(mt + MT_PROJ); float* MO = (float*)(mt + MT_O); bf16* MOG = (bf16*)(mt + MT_OG); float* MH = (float*)(mt + MT_H);
    bf16* MACT = (bf16*)(mt + MT_ACT); float* ZM = (float*)(mt + MT_Z);
    bf16* MQDF = (bf16*)(mt + MT_QDF); bf16* MKDNTF = (bf16*)(mt + MT_KDNTF); bf16* MSC = (bf16*)(mt + MT_SC); float* MEBL = (float*)(mt + MT_EBL);

    for (int u = tid; u < 1024 / 4; u += NWAVES * 64) ((LAS unsigned*)(lds + LDSCTL_OFF))[u] = 0u;
    __syncthreads();
    const int lo = args.ph_lo, hi = args.ph_hi;
    XcdBarrier bar; bar.bar = ctl + CW_BAR + args.li * XCD_BAR_WORDS; bar.x = 0; bar.st = nullptr;
    if (hi - lo > 1) bar = xcd_barrier_post(ctl + CW_BAR + args.li * XCD_BAR_WORDS, MISC + 8);
#ifndef ONLY_PHASE
#define ONLY_PHASE -1
#endif
#define IN(k) (lo <= (k) && (k) < hi && (ONLY_PHASE < 0 || (k) == ONLY_PHASE))
#define SEAM(k) do { if (IN(k) && IN((k) + 1)) xcd_barrier(bar); } while (0)

    if (IN(0)) {
        LAS float* scr = (LAS float*)(lds + RING_OFF + wave * 16384);
        cvt_task<0>(args.in[I_GWIN], D, GIN, GIN, args.in[I_NMIX], W_GIN, scr, gw, NGW, lane);
        cvt_task<0>(args.in[I_GWOUT], GV, D, D, nullptr, W_GOUT, scr, gw, NGW, lane);
        cvt_task<1>(args.in[I_FGATE], D, FF, FF, args.in[I_NFFN], W_GU0, scr, gw, NGW, lane);
        cvt_task<2>(args.in[I_FUP], D, FF, FF, args.in[I_NFFN], W_GU0, scr, gw, NGW, lane);
        cvt_task<0>(args.in[I_FDOWN], FF, D, D, nullptr, W_DN0, scr, gw, NGW, lane);
        cvt_task<0>(args.in[I_CWIN], D, NQKVR, D, args.in[I_NMIX] + D, W_CIN, scr, gw, NGW, lane);
        cvt_task<1>(args.in[I_CWIN] + D, D, NQKVR, D, args.in[I_NMIX] + D, W_CIN + (size_t)D * D, scr, gw, NGW, lane);
        cvt_task<2>(args.in[I_CWIN] + 2 * D, D, NQKVR, D, args.in[I_NMIX] + D, W_CIN + (size_t)D * D, scr, gw, NGW, lane);
        cvt_task<0>(args.in[I_CWOUT], D, D, D, nullptr, W_COUT, scr, gw, NGW, lane);
        cvt_task<1>(args.in[I_FGATE] + (size_t)D * FF, D, FF, FF, args.in[I_NFFN] + D, W_GU1, scr, gw, NGW, lane);
        cvt_task<2>(args.in[I_FUP] + (size_t)D * FF, D, FF, FF, args.in[I_NFFN] + D, W_GU1, scr, gw, NGW, lane);
        cvt_task<0>(args.in[I_FDOWN] + (size_t)FF * D, FF, D, D, nullptr, W_DN1, scr, gw, NGW, lane);
        for (int blk = bx; blk < M / 64; blk += G)
            for (int i = 0; i < 8; ++i) { const int m = blk * 64 + wave * 8 + i; row_to_bf16_ss(x + (size_t)m * D, XB + (size_t)m * D, SS + m, lane); }
        if (bx == 0) for (int i = 0; i < 2; ++i) { const int m = wave * 2 + i; row_to_bf16_ss(args.in[I_META] + (size_t)m * D, MXB + (size_t)m * D, MSS + m, lane); }
        for (int oc = bx; oc < NMETA * GR; oc += G) {
            const int r = oc >> 4, c = oc & 15; const float* mr = args.in[I_META] + (size_t)r * D; const float* gm = args.in[I_NMIX]; const float* wi = args.in[I_GWIN] + NQKVR + c;
            float ssq = 0.f, acc = 0.f;
#pragma unroll
            for (int j = 0; j < 8; ++j) { const int k = tid + 512 * j; const float xv = mr[k]; ssq += xv * xv; acc += xv * gm[k] * wi[(size_t)k * GIN]; }
            ssq = wave_sum(ssq); acc = wave_sum(acc);
            LAS float* rd = (LAS float*)(lds + RING_OFF + 8 * 16384);
            __syncthreads(); if (lane == 0) { rd[wave] = ssq; rd[8 + wave] = acc; } __syncthreads();
            if (tid == 0) { float s2 = 0.f, a2 = 0.f; for (int w = 0; w < 8; ++w) { s2 += rd[w]; a2 += rd[8 + w]; } MPROJ[(size_t)r * MGIN + NQKVR + c] = a2 * rstd_of(s2); } }
    }
    SEAM(0);

    if (IN(1)) {
        { TE_ALow e{ALOW, SS}; thin_gemm16<false>(lds + RING_OFF, W_GIN + (size_t)NQKVR * D, XB, D, M / 16, 0, e, bx, G); }
        { LAS float* rt = (LAS float*)(lds + RING_OFF + 16384); thin_row_rstd(rt, args.in[I_META]); TE_MProj e{MPROJ, rt}; thin_gemm16<false>(lds + RING_OFF, MXB, W_GIN, D, NQKVR / 16, 0, e, bx, G); }
        pg8::Gemm g{XB, W_GIN, M, NQKVR, D}; pg8::RstdOrder S; S.init(M, NQKVR, G, bx); S.ssp = nullptr; S.ss0 = SS; S.npn = 0; S.cnt = 0;
        pg8::EpiScaleBf16 E{PROJ, NQKVR, 0};
        pg8::gemm_phase<pg8::EpiScaleBf16, pg8::RstdOrder, true, true>(lds + RING_OFF, g, S, E);
    }
    SEAM(1);

    if (IN(2)) {
        LAS unsigned char* sm = lds + RING_OFF;
        if (bx < GH) gla_prep_item(sm, true, PROJ, ALOW, MPROJ, bx, args.in[I_GWA2], args.in[I_GBA], MQDF + (size_t)bx * GLA_ITEM_FR, MKDNTF + (size_t)bx * GLA_ITEM_FR, MSC + (size_t)bx * 4096, MEBL + bx * DK);
        for (int it = bx; it < NB * 64 * GH; it += G) { const int h = it & 3; const size_t m0 = (size_t)(it >> 2) * 64;
            gla_prep_item(sm, false, PROJ + m0 * NQKVR, ALOW + m0 * 16, MPROJ, h, args.in[I_GWA2], args.in[I_GBA], QDF + (size_t)it * GLA_ITEM_FR, KDNTF + (size_t)it * GLA_ITEM_FR, SC + (size_t)it * 4096, EBL + (size_t)it * DK); }
    }
    SEAM(2);

#ifndef NO_SCAN
    if (IN(3)) gla_scan(lds + RING_OFF, PROJ, MPROJ, QDF, KDNTF, SC, EBL, MQDF, MKDNTF, MSC, MEBL, O, MO);
#endif
    SEAM(3);

    if (IN(4)) {
        const float* hn = args.in[I_GHN];
        for (int it = gw; it < M * GH; it += NGW) { const int m = it >> 2, h = it & 3; f32x4 rv[4];
            const v2u* rp = (const v2u*)(PROJ + (size_t)m * NQKVR + 2 * QK + GV + h * DV);
#pragma unroll
            for (int j = 0; j < 4; ++j) { const v2u w = rp[lane + 64 * j]; rv[j] = (f32x4){bflo(w.x), bfhi(w.x), bflo(w.y), bfhi(w.y)}; }
            gate_item<true>(O + (size_t)m * GV + h * DV, hn, rv, OG + (size_t)m * GV + h * DV, lane); }
        if (gw < NMETA * GH) { const int m = gw >> 2, h = gw & 3; f32x4 rv[4];
#pragma unroll
            for (int j = 0; j < 4; ++j) rv[j] = *((const f32x4*)(MPROJ + (size_t)m * MGIN + 2 * QK + GV + h * DV) + lane + 64 * j);
            gate_item<false>(MO + (size_t)m * GV + h * DV, hn, rv, MOG + (size_t)m * GV + h * DV, lane); }
    }
    SEAM(4);

    if (IN(5)) {
        { TE_MResid e{args.in[I_META], MH, MXB, MSS + MSS_STRIDE}; thin_gemm16<false>(lds + RING_OFF, MOG, W_GOUT, GV, D / 16, 0, e, bx, G); }
        pg8::Gemm g{OG, W_GOUT, M, D, GV}; pg8::StaticOrder S; S.init(M, D, G, bx);
        pg8::EpiResid<false> E{x, XB, SSP, D};
        pg8::gemm_phase<pg8::EpiResid<false>, pg8::StaticOrder, true, true>(lds + RING_OFF, g, S, E);
    }
    SEAM(5);

    if (IN(6)) {
        const bool thin_in_tail = G == 256;
        if (!thin_in_tail) { LAS float* rt = (LAS float*)(lds + RING_OFF + 16384); thin_row_rstd(rt, MH); TE_MSwiGLU e{MACT, rt}; thin_gemm16<true>(lds + RING_OFF, MXB, W_GU0, D, FF / 16, 128, e, bx, G); }
        pg8::Gemm g{XB, W_GU0, M, NGU, D}; pg8::RstdOrder S; S.init(M, NGU, G, bx); S.ssp = SSP; S.ss0 = nullptr; S.npn = D / 256; S.cnt = 0;
        pg8::EpiSwiGLU E{ACT, FF, 0};
        pg8::gemm_phase<pg8::EpiSwiGLU, pg8::RstdOrder, true, true>(lds + RING_OFF, g, S, E);
        if (thin_in_tail && bx >= 128) { __syncthreads();
            LAS float* rt = (LAS float*)(lds + RING_OFF + 16384); thin_row_rstd(rt, MH); TE_MSwiGLU e{MACT, rt}; thin_gemm16<true>(lds + RING_OFF, MXB, W_GU0, D, FF / 16, 128, e, bx - 128, 128); }
    }
    SEAM(6);

    if (IN(7)) {
        { TE_MResid e{MH, MH, MXB, MSS + 2 * MSS_STRIDE}; thin_gemm16<false>(lds + RING_OFF, MACT, W_DN0, FF, D / 16, 0, e, bx, G); }
        pg8::Gemm g{ACT, W_DN0, M, D, FF}; pg8::StaticOrderPN S; S.init(M, D, G, bx);
        pg8::EpiResid<true> E{nullptr, XB, SSP + SSP_N, D};
        pg8::gemm_phase<pg8::EpiResid<true>, pg8::StaticOrderPN, true, true>(lds + RING_OFF, g, S, E);
    }
    SEAM(7);

    if (IN(8)) {
        { LAS float* rt = (LAS float*)(lds + RING_OFF + 16384); thin_row_rstd(rt, MH); TE_MConvZ e{ZM, rt}; thin_gemm16<true>(lds + RING_OFF, MXB, W_CIN, D, D / 16, 128, e, bx, G); }
        { pg8::Gemm g{XB, W_CIN, M, D, D}; pg8::RstdOrder S; S.init(M, D, G, bx); S.ssp = SSP + SSP_N; S.ss0 = nullptr; S.npn = D / 256; S.cnt = 0;
          pg8::EpiScaleBf16 E{CBG, D, 0};
          pg8::gemm_phase<pg8::EpiScaleBf16, pg8::RstdOrder, true, true>(lds + RING_OFF, g, S, E); }
        __syncthreads();
        { pg8::Gemm g{XB, W_CIN + (size_t)D * D, M, 2 * D, D}; pg8::RstdOrder S; S.init(M, 2 * D, G, bx); S.ssp = SSP + SSP_N; S.ss0 = nullptr; S.npn = D / 256; S.cnt = 0;
          pg8::EpiMul E{CZ, D, 0};
          pg8::gemm_phase<pg8::EpiMul, pg8::RstdOrder, true, true>(lds + RING_OFF, g, S, E); }
    }
    SEAM(8);

    if (IN(9)) {
        const float* cw = args.in[I_CW];
        const int c0 = tid * 8;
        float w0[8], w1[8], w2[8];
#pragma unroll
        for (int j = 0; j < 8; ++j) { w0[j] = cw[c0 + j]; w1[j] = cw[D + c0 + j]; w2[j] = cw[2 * D + c0 + j]; }
        for (int run = bx; run < M / 64; run += G) {
            const int m0 = run * 64, s0 = m0 & (SEQ - 1);
            float z1[8], z2[8];
            if (s0 == 0) {
#pragma unroll
                for (int j = 0; j < 8; ++j) { z2[j] = ZM[c0 + j]; z1[j] = ZM[D + c0 + j]; }
            } else {
                const v4u zq2 = *(const v4u*)(CZ + (size_t)(m0 - 2) * D + c0), zq1 = *(const v4u*)(CZ + (size_t)(m0 - 1) * D + c0);
#pragma unroll
                for (int j = 0; j < 4; ++j) { z2[2 * j] = bflo(zq2[j]); z2[2 * j + 1] = bfhi(zq2[j]); z1[2 * j] = bflo(zq1[j]); z1[2 * j + 1] = bfhi(zq1[j]); }
            }
#pragma unroll 4
            for (int rr = 0; rr < 64; ++rr) {
                const v4u bg = *(const v4u*)(CBG + (size_t)(m0 + rr) * D + c0), zq = *(const v4u*)(CZ + (size_t)(m0 + rr) * D + c0);
                float z[8], y[8];
#pragma unroll
                for (int j = 0; j < 4; ++j) { z[2 * j] = bflo(zq[j]); z[2 * j + 1] = bfhi(zq[j]); }
#pragma unroll
                for (int j = 0; j < 8; ++j) { const float cv = w2[j] * z[j] + w1[j] * z1[j] + w0[j] * z2[j]; const float bgf = (j & 1) ? bfhi(bg[j >> 1]) : bflo(bg[j >> 1]); y[j] = bgf * cv; z2[j] = z1[j]; z1[j] = z[j]; }
                v4u o; o.x = pk2(y[0], y[1]); o.y = pk2(y[2], y[3]); o.z = pk2(y[4], y[5]); o.w = pk2(y[6], y[7]);
                *(v4u*)(OG + (size_t)(m0 + rr) * D + c0) = o;
            }
        }
    }
    SEAM(9);

    if (IN(10)) {
        pg8::Gemm g{OG, W_COUT, M, D, D}; pg8::StaticOrder S; S.init(M, D, G, bx);
        pg8::EpiResid<true> E{nullptr, XB, SSP + 2 * SSP_N, D};
        pg8::gemm_phase<pg8::EpiResid<true>, pg8::StaticOrder, true, true>(lds + RING_OFF, g, S, E);
    }
    SEAM(10);

    if (IN(11)) {
        pg8::Gemm g{XB, W_GU1, M, NGU, D}; pg8::RstdOrder S; S.init(M, NGU, G, bx); S.ssp = SSP + 2 * SSP_N; S.ss0 = nullptr; S.npn = D / 256; S.cnt = 0;
        pg8::EpiSwiGLU E{ACT, FF, 0};
        pg8::gemm_phase<pg8::EpiSwiGLU, pg8::RstdOrder, true, true>(lds + RING_OFF, g, S, E);
    }
    SEAM(11);

    if (IN(12)) {
        pg8::Gemm g{ACT, W_DN1, M, D, FF}; pg8::StaticOrderPN S; S.init(M, D, G, bx);
        pg8::EpiResid<true> E{nullptr, XB, SSP, D};
        pg8::gemm_phase<pg8::EpiResid<true>, pg8::StaticOrderPN, true, true>(lds + RING_OFF, g, S, E);
    }
    SEAM(12);

    if (IN(13)) {
        const float* gf = args.in[I_NFINAL];
        bool bad = false;
        for (int r = 0; r < N_PHASES; ++r) bad |= __hip_atomic_load(ctl + CW_BAR + r * XCD_BAR_WORDS + XB_TMO, __ATOMIC_RELAXED, __HIP_MEMORY_SCOPE_AGENT) != 0u;
        for (int m = gw; m < M; m += NGW) { const v4u* xr = (const v4u*)(XB + (size_t)m * D) + lane; f32x4* row = (f32x4*)(out + (size_t)m * D) + 2 * lane; v4u q[8]; float ssq = 0.f;
#pragma unroll
            for (int j = 0; j < 8; ++j) { q[j] = xr[64 * j];
#pragma unroll
                for (int e = 0; e < 4; ++e) { const float lo = bflo(q[j][e]), hi = bfhi(q[j][e]); ssq += lo * lo + hi * hi; } }
            const float rs = bad ? __builtin_nanf("") : rstd_of(wave_sum(ssq));
#pragma unroll
            for (int j = 0; j < 8; ++j) { const f32x4 g0 = *((const f32x4*)gf + 2 * lane + 128 * j), g1 = *((const f32x4*)gf + 2 * lane + 128 * j + 1);
                f32x4 o0, o1; o0.x = bflo(q[j].x) * rs * g0.x; o0.y = bfhi(q[j].x) * rs * g0.y; o0.z = bflo(q[j].y) * rs * g0.z; o0.w = bfhi(q[j].y) * rs * g0.w;
                o1.x = bflo(q[j].z) * rs * g1.x; o1.y = bfhi(q[j].z) * rs * g1.y; o1.z = bflo(q[j].w) * rs * g1.z; o1.w = bfhi(q[j].w) * rs * g1.w;
                row[128 * j] = o0; row[128 * j + 1] = o1; } }
    }
#undef IN
#undef SEAM
}

extern "C" void kernel_launch(void* const* d_in, const int* in_sizes, int n_in, void* d_out, int out_size, void* d_ws, size_t ws_size, hipStream_t stream) {
    static int grid = 0;
    if (grid == 0) {
        if (n_in != 16 || in_sizes[0] != M * D || out_size != M * D || ws_size < WS_END) { fprintf(stderr, "kernel_launch: unexpected problem (n_in %d, in0 %d, out %d, ws %zu < %zu)\n", n_in, n_in > 0 ? in_sizes[0] : -1, out_size, ws_size, (size_t)WS_END); grid = -1; return; }
        int dev = 0, cus = 0, per_cu = 0;
        if (hipGetDevice(&dev) != hipSuccess || hipDeviceGetAttribute(&cus, hipDeviceAttributeMultiprocessorCount, dev) != hipSuccess) { grid = -1; return; }
        if (hipFuncSetAttribute((const void*)trunk_fwd, hipFuncAttributeMaxDynamicSharedMemorySize, LDS_BYTES) != hipSuccess) { fprintf(stderr, "kernel_launch: hipFuncSetAttribute failed\n"); grid = -1; return; }
        if (hipOccupancyMaxActiveBlocksPerMultiprocessor(&per_cu, (const void*)trunk_fwd, NWAVES * 64, LDS_BYTES) != hipSuccess || per_cu < 1)
            fprintf(stderr, "kernel_launch: note: occupancy query reports %d workgroups per CU\n", per_cu);
        (void)hipGetLastError();
        grid = cus;
    }
    if (grid < 0) return;
#if DIAG_POISON
    (void)hipMemsetAsync((char*)d_ws + CTL_ZERO_BYTES, 0xAA, WS_END - CTL_ZERO_BYTES, stream);
    (void)hipMemsetAsync(d_out, 0xAA, (size_t)M * D * 4, stream);
#endif
    if (hipMemsetAsync((char*)d_ws + WS_CTL, 0, CTL_ZERO_BYTES, stream) != hipSuccess) { fprintf(stderr, "kernel_launch: memset failed\n"); return; }
    Args a{};
    for (int i = 0; i < 16; ++i) a.in[i] = (const float*)d_in[i];
    a.out = (float*)d_out; a.ws = (unsigned char*)d_ws;
    int li = 0;
    for (int p0 = 0; p0 < N_PHASES; ++li) {
        int p1 = p0 + 1; while (p1 < N_PHASES && !((MK_CUTS >> (p1 - 1)) & 1u)) ++p1;
        a.ph_lo = p0; a.ph_hi = p1; a.li = li; p0 = p1;
        hipLaunchKernelGGL(trunk_fwd, dim3(grid), dim3(NWAVES * 64), LDS_BYTES, stream, a);
        const hipError_t le = hipPeekAtLastError();
        if (le != hipSuccess) { fprintf(stderr, "kernel_launch: launch %d failed: %s\n", li, hipGetErrorName(le)); break; }
    }
}
```

```cpp
#include <hip/hip_runtime.h>
#include <cstdio>
#include <cstdint>
namespace pg8 {
#define PG8_LAS __attribute__((address_space(3)))
typedef unsigned short bf16_t;
typedef short bf16x8 __attribute__((ext_vector_type(8)));
typedef float f32x4 __attribute__((ext_vector_type(4)));
typedef unsigned u32x4 __attribute__((ext_vector_type(4)));
constexpr int BM = 256, BK = 64, HALF = 128, HTB = HALF * BK * 2  , STAGE_BYTES = 8 * HTB, NXCD = 8, WGM = 8;

__host__ __device__ __forceinline__ int lds_byte(int r, int c) { const int st = (r >> 4) * 2 + (c >> 5), rr = r & 15, cc = c & 31, ob = rr * 64 + cc * 2; return st * 1024 + (ob ^ (((ob >> 9) & 1) << 5)); }
__host__ __device__ __forceinline__ void stage_rc(int b, int& R, int& C) { const int st = b / 1024, sb = b % 1024, swz = sb ^ (((sb >> 9) & 1) << 5); R = (st >> 1) * 16 + swz / 64; C = (st & 1) * 32 + (swz % 64) / 2; }
__host__ __device__ __forceinline__ int perm32(int rho) { const int n = rho >> 4, i = rho & 15; return 8 * (i >> 2) + 4 * n + (i & 3); }

struct Unit { int pm, pn; };
struct Gemm { const bf16_t* A; const bf16_t* Bt; int M, N, K; };

struct StaticOrder {
    int nM, nN, nwg, G, c;
    __host__ __device__ void init(int M, int N, int G_, int c_) { nM = M / BM; nN = N / BM; nwg = nM * nN; G = G_; c = c_; }
    __host__ __device__ bool next(int i, Unit& u) const {
        const long L = (long)i * G + c; if (L >= nwg) return false;
        int wgid = (int)L; { const int q = nwg / NXCD, r = nwg % NXCD, xcd = wgid % NXCD, off = wgid / NXCD; wgid = (xcd < r ? xcd * (q + 1) : r * (q + 1) + (xcd - r) * q) + off; }
        const int nig = WGM * nN, gid = wgid / nig, fm = gid * WGM, gsz = (nM - fm) < WGM ? (nM - fm) : WGM;
        u.pm = fm + ((wgid % nig) % gsz); u.pn = (wgid % nig) / gsz; return true;
    }
    __device__ __forceinline__ void a_ready(const Unit&) const {}
    __device__ __forceinline__ void first_ready(const Unit&) const {}
    __device__ __forceinline__ void done(const Unit&) const {}
    __device__ __forceinline__ void after_epi(const Unit&) const {}
};


struct StaticOrderPN : StaticOrder {
    __host__ __device__ bool next(int i, Unit& u) const {
        const long L = (long)i * G + c; if (L >= nwg) return false;
        int wgid = (int)L; { const int q = nwg / NXCD, r = nwg % NXCD, xcd = wgid % NXCD, off = wgid / NXCD; wgid = (xcd < r ? xcd * (q + 1) : r * (q + 1) + (xcd - r) * q) + off; }
        const int nig = WGM * nN, gid = wgid / nig, fm = gid * WGM, idx = wgid % nig;
        u.pm = fm + idx / nN; u.pn = idx % nN; return true;
    }
};

__device__ __forceinline__ unsigned cvt_pk_bf16(float lo, float hi) { unsigned r; asm volatile("v_cvt_pk_bf16_f32 %0, %1, %2" : "=v"(r) : "v"(lo), "v"(hi)); return r; }
__device__ __forceinline__ float rstd_of(float ss) { return 1.0f / sqrtf(ss * (1.0f / 4096.0f) + 1e-6f); }
__device__ __forceinline__ float silu_f(float x) { return x * __builtin_amdgcn_rcpf(1.0f + __expf(-x)); }

struct EpiScaleBf16 {
    static constexpr bool PERM = true, AFTER_DRAIN = false;
    bf16_t* O; int ldc; mutable int cnt;
    __device__ __forceinline__ void operator()(const f32x4 (&acc)[2][2][4][2], const Unit& u, int wr, int wc, int fr, int fq) const {
        const int row0 = u.pm * BM + wr * 64 + fr, col0 = u.pn * BM + wc * 32 + 8 * fq; const PG8_LAS float* tb = (const PG8_LAS float*)(unsigned)131072 + (cnt & 1) * 256 + wr * 64 + fr; ++cnt;
        float scv[2][4];
#pragma unroll
        for (int ai = 0; ai < 2; ++ai)
#pragma unroll
            for (int m = 0; m < 4; ++m) scv[ai][m] = tb[ai * HALF + m * 16];
#pragma unroll
        for (int ai = 0; ai < 2; ++ai)
#pragma unroll
            for (int m = 0; m < 4; ++m) { const int row = row0 + ai * HALF + m * 16; const float sc = scv[ai][m]; bf16_t* rowp = O + (size_t)row * ldc + col0;
#pragma unroll
                for (int bj = 0; bj < 2; ++bj) { const f32x4 v0 = acc[ai][bj][m][0] * sc, v1 = acc[ai][bj][m][1] * sc;
                    u32x4 w; w.x = cvt_pk_bf16(v0[0], v0[1]); w.y = cvt_pk_bf16(v0[2], v0[3]); w.z = cvt_pk_bf16(v1[0], v1[1]); w.w = cvt_pk_bf16(v1[2], v1[3]);
                    *(u32x4*)(rowp + bj * HALF) = w; } }
    }
};
struct EpiSwiGLU {
    static constexpr bool PERM = true, AFTER_DRAIN = false;
    bf16_t* O; int ldc; mutable int cnt;
    __device__ __forceinline__ void operator()(const f32x4 (&acc)[2][2][4][2], const Unit& u, int wr, int wc, int fr, int fq) const {
        const int row0 = u.pm * BM + wr * 64 + fr, col0 = u.pn * HALF + wc * 32 + 8 * fq; const PG8_LAS float* tb = (const PG8_LAS float*)(unsigned)131072 + (cnt & 1) * 256 + wr * 64 + fr; ++cnt;
        float scv[2][4];
#pragma unroll
        for (int ai = 0; ai < 2; ++ai)
#pragma unroll
            for (int m = 0; m < 4; ++m) scv[ai][m] = tb[ai * HALF + m * 16];
#pragma unroll
        for (int ai = 0; ai < 2; ++ai)
#pragma unroll
            for (int m = 0; m < 4; ++m) { const int row = row0 + ai * HALF + m * 16; const float sc = scv[ai][m];
                float a[8];
#pragma unroll
                for (int n = 0; n < 2; ++n)
#pragma unroll
                    for (int j = 0; j < 4; ++j) { const float g = acc[ai][0][m][n][j] * sc, up = acc[ai][1][m][n][j] * sc; a[4 * n + j] = silu_f(g) * up; }
                u32x4 w; w.x = cvt_pk_bf16(a[0], a[1]); w.y = cvt_pk_bf16(a[2], a[3]); w.z = cvt_pk_bf16(a[4], a[5]); w.w = cvt_pk_bf16(a[6], a[7]);
                *(u32x4*)(O + (size_t)row * ldc + col0) = w; }
    }
};
struct EpiMul {
    static constexpr bool PERM = true, AFTER_DRAIN = false;
    bf16_t* O; int ldc; mutable int cnt;
    __device__ __forceinline__ void operator()(const f32x4 (&acc)[2][2][4][2], const Unit& u, int wr, int wc, int fr, int fq) const {
        const int row0 = u.pm * BM + wr * 64 + fr, col0 = u.pn * HALF + wc * 32 + 8 * fq; const PG8_LAS float* tb = (const PG8_LAS float*)(unsigned)131072 + (cnt & 1) * 256 + wr * 64 + fr; ++cnt;
        float scv[2][4];
#pragma unroll
        for (int ai = 0; ai < 2; ++ai)
#pragma unroll
            for (int m = 0; m < 4; ++m) scv[ai][m] = tb[ai * HALF + m * 16];
#pragma unroll
        for (int ai = 0; ai < 2; ++ai)
#pragma unroll
            for (int m = 0; m < 4; ++m) { const int row = row0 + ai * HALF + m * 16; const float sc = scv[ai][m], sc2 = sc * sc;
                float a[8];
#pragma unroll
                for (int n = 0; n < 2; ++n)
#pragma unroll
                    for (int j = 0; j < 4; ++j) a[4 * n + j] = (acc[ai][0][m][n][j] * acc[ai][1][m][n][j]) * sc2;
                u32x4 w; w.x = cvt_pk_bf16(a[0], a[1]); w.y = cvt_pk_bf16(a[2], a[3]); w.z = cvt_pk_bf16(a[4], a[5]); w.w = cvt_pk_bf16(a[6], a[7]);
                *(u32x4*)(O + (size_t)row * ldc + col0) = w; }
    }
};
template <bool RB>
struct EpiResid {
    static constexpr bool PERM = true, AFTER_DRAIN = false;
    static constexpr int MB = RB ? 4 : 2;
    const float* resid; bf16_t* XB; float* ss_out; int ldc;
    __device__ __forceinline__ void operator()(const f32x4 (&acc)[2][2][4][2], const Unit& u, int wr, int wc, int fr, int fq) const {
        const int row0 = u.pm * BM + wr * 64 + fr, col0 = u.pn * BM + wc * 32 + 8 * fq;
#pragma unroll
        for (int ai = 0; ai < 2; ++ai)
#pragma unroll
          for (int mb = 0; mb < 4; mb += MB) {
            u32x4 rb[MB][2]; f32x4 rf[RB ? 1 : MB][2][2];
#pragma unroll
            for (int mm = 0; mm < MB; ++mm) { const size_t off = (size_t)(row0 + ai * HALF + (mb + mm) * 16) * ldc + col0;
#pragma unroll
                for (int bj = 0; bj < 2; ++bj) {
                    if constexpr (RB) rb[mm][bj] = *(const u32x4*)(XB + off + bj * HALF);
                    else { rf[mm][bj][0] = *(const f32x4*)(resid + off + bj * HALF); rf[mm][bj][1] = *(const f32x4*)(resid + off + bj * HALF + 4); } } }
#pragma unroll
            for (int mm = 0; mm < MB; ++mm) { const int m = mb + mm, row = row0 + ai * HALF + m * 16; const size_t off = (size_t)row * ldc + col0; float s = 0.f;
#pragma unroll
                for (int bj = 0; bj < 2; ++bj) { f32x4 r0, r1;
                    if constexpr (RB) { const u32x4 q = rb[mm][bj];
                        r0[0] = __builtin_bit_cast(float, q.x << 16); r0[1] = __builtin_bit_cast(float, q.x & 0xffff0000u); r0[2] = __builtin_bit_cast(float, q.y << 16); r0[3] = __builtin_bit_cast(float, q.y & 0xffff0000u);
                        r1[0] = __builtin_bit_cast(float, q.z << 16); r1[1] = __builtin_bit_cast(float, q.z & 0xffff0000u); r1[2] = __builtin_bit_cast(float, q.w << 16); r1[3] = __builtin_bit_cast(float, q.w & 0xffff0000u); }
                    else { r0 = rf[mm][bj][0]; r1 = rf[mm][bj][1]; }
                    const f32x4 v0 = acc[ai][bj][m][0] + r0, v1 = acc[ai][bj][m][1] + r1;
                    u32x4 w; w.x = cvt_pk_bf16(v0[0], v0[1]); w.y = cvt_pk_bf16(v0[2], v0[3]); w.z = cvt_pk_bf16(v1[0], v1[1]); w.w = cvt_pk_bf16(v1[2], v1[3]);
                    *(u32x4*)(XB + off + bj * HALF) = w;
                    s += (v0[0] * v0[0] + v0[1] * v0[1]) + (v0[2] * v0[2] + v0[3] * v0[3]) + (v1[0] * v1[0] + v1[1] * v1[1]) + (v1[2] * v1[2] + v1[3] * v1[3]); }
                s += __shfl_xor(s, 16); s += __shfl_xor(s, 32);
                if (fq == 0) ss_out[((size_t)(u.pm * (ldc / BM) + u.pn) * BM + (row - u.pm * BM)) * 4 + wc] = s; }
            asm volatile("" ::: "memory"); }
    }
};

struct RstdOrder : StaticOrder {
    const float* ssp; const float* ss0; int npn; mutable int cnt; mutable int pmA, pmB;
    static __device__ __forceinline__ PG8_LAS float* tbl() { return (PG8_LAS float*)(unsigned)131072; }
    __device__ __forceinline__ void build(const Unit& u) const {
        const int par = cnt & 1; const bool same = cnt >= 2 && (par ? pmB : pmA) == u.pm; if (par) pmB = u.pm; else pmA = u.pm; ++cnt; const int tid = threadIdx.x;
        if (same) return;
        if (tid < 256) { float s;
            if (ssp) { const char* base = (const char*)(ssp + (size_t)(u.pm * npn) * 1024); int to = tid * 16; asm volatile("" : "+v"(to));
                s = 0.f;
#pragma unroll
                for (int pn = 0; pn < 16; ++pn) { const f32x4 v = *(const f32x4*)(base + (size_t)pn * 4096 + (size_t)(unsigned)to); s += (v[0] + v[1]) + (v[2] + v[3]); } }
            else s = ss0[u.pm * BM + tid];
            tbl()[par * 256 + tid] = rstd_of(s); }
    }
    __device__ __forceinline__ void first_ready(const Unit& u) const { build(u); }
    __device__ __forceinline__ void after_epi(const Unit& u) const { build(u); }
};

template <class Epi, class Sched, bool ALIGN_EPI = false, bool SP2 = false>
__device__ __forceinline__ void gemm_phase(PG8_LAS unsigned char* lds, const Gemm g, const Sched& S, const Epi& E) {
    const int tid = threadIdx.x, wid = __builtin_amdgcn_readfirstlane(tid >> 6), lane = tid & 63, wr = wid >> 2, wc = wid & 3, fr = lane & 15, fq = lane >> 4;
    const int K = g.K, nt = K / BK;
    unsigned voffA[2], voffB[2];
#pragma unroll
    for (int i = 0; i < 2; ++i) { int R, C; stage_rc(tid * 16 + i * 8192, R, C); const int Rb = Epi::PERM ? ((R & ~31) + perm32(R & 31)) : R;
        voffA[i] = (unsigned)(R * K + C) * 2u; voffB[i] = (unsigned)(Rb * K + C) * 2u; }
    const size_t kstep = (size_t)(BK * 2);
    const size_t hstep = (size_t)HALF * K * 2;
    const size_t tstep = 2 * hstep;
    const unsigned ldsw = (unsigned)wid * 1024u;
    const int aoff = lds_byte(wr * 64 + fr, fq * 8), boff = lds_byte(wc * 32 + fr, fq * 8);
#define PG8_SA(b, h) (((b) * 2 + (h)) * HTB)
#define PG8_SB(b, h) ((4 + (b) * 2 + (h)) * HTB)
#define PG8_STAGE(bufoff, gbase, voff) do { _Pragma("unroll") for (int _i = 0; _i < 2; ++_i) \
        __builtin_amdgcn_global_load_lds((const unsigned*)((const char*)(gbase) + (voff)[_i]), (PG8_LAS unsigned*)(lds + (bufoff) + ldsw + _i * 8192), 16, 0, 0); } while (0)
#define PG8_LDA(dst, b, h) do { _Pragma("unroll") for (int m = 0; m < 4; ++m) _Pragma("unroll") for (int k = 0; k < 2; ++k) dst[m][k] = *(const PG8_LAS bf16x8*)(lds + PG8_SA(b, h) + aoff + m * 2048 + k * 1024); } while (0)
#define PG8_LDB(dst, b, h) do { _Pragma("unroll") for (int n = 0; n < 2; ++n) _Pragma("unroll") for (int k = 0; k < 2; ++k) dst[n][k] = *(const PG8_LAS bf16x8*)(lds + PG8_SB(b, h) + boff + n * 2048 + k * 1024); } while (0)
#define PG8_MMA(ai, bj, At, Bt) do { __builtin_amdgcn_s_setprio(1); _Pragma("unroll") for (int m = 0; m < 4; ++m) _Pragma("unroll") for (int n = 0; n < 2; ++n) _Pragma("unroll") for (int k = 0; k < 2; ++k) \
        acc[ai][bj][m][n] = __builtin_amdgcn_mfma_f32_16x16x32_bf16(Bt[n][k], At[m][k], acc[ai][bj][m][n], 0, 0, 0); __builtin_amdgcn_s_setprio(0); } while (0)
#define PG8_WAIT_V(n) asm volatile("s_waitcnt vmcnt(" #n ")" ::: "memory")
#define PG8_WAIT_L(n) asm volatile("s_waitcnt lgkmcnt(" #n ")" ::: "memory")
#define PG8_BAR __builtin_amdgcn_s_barrier()
#define PG8_SCHED __builtin_amdgcn_sched_barrier(0)
    Unit cur, nxt; int ui = 0;
    if (!S.next(0, cur)) return;
    f32x4 acc[2][2][4][2];
#pragma unroll
    for (int a = 0; a < 2; ++a)
#pragma unroll
        for (int b = 0; b < 2; ++b)
#pragma unroll
            for (int m = 0; m < 4; ++m)
#pragma unroll
                for (int n = 0; n < 2; ++n) acc[a][b][m][n] = (f32x4){0.f, 0.f, 0.f, 0.f};
    bf16x8 At[4][2], B0[2][2], B1[2][2];
    const char* cA = (const char*)g.A + (size_t)cur.pm * tstep; const char* cB = (const char*)g.Bt + (size_t)cur.pn * tstep;
    S.first_ready(cur);
    if constexpr (SP2) {
        PG8_STAGE(PG8_SB(0, 0), cB, voffB); PG8_STAGE(PG8_SB(0, 1), cB + hstep, voffB); PG8_STAGE(PG8_SA(0, 0), cA, voffA); PG8_STAGE(PG8_SA(0, 1), cA + hstep, voffA);
        if (wr == 1) PG8_BAR;
        PG8_WAIT_V(2); PG8_BAR;
        PG8_STAGE(PG8_SB(1, 0), cB + kstep, voffB); PG8_STAGE(PG8_SA(1, 0), cA + kstep, voffA); PG8_STAGE(PG8_SB(1, 1), cB + hstep + kstep, voffB);
        PG8_WAIT_V(6); PG8_BAR;
    } else {
        PG8_STAGE(PG8_SB(0, 0), cB, voffB); PG8_STAGE(PG8_SA(0, 0), cA, voffA); PG8_STAGE(PG8_SB(0, 1), cB + hstep, voffB); PG8_STAGE(PG8_SA(0, 1), cA + hstep, voffA);
        if (wr == 1) PG8_BAR;
        PG8_WAIT_V(4); PG8_BAR;
        PG8_STAGE(PG8_SB(1, 0), cB + kstep, voffB); PG8_STAGE(PG8_SA(1, 0), cA + kstep, voffA); PG8_STAGE(PG8_SB(1, 1), cB + hstep + kstep, voffB);
        PG8_WAIT_V(6); PG8_BAR;
    }
    for (;;) {
        const bool has_next = S.next(ui + 1, nxt);
        const char* nA = has_next ? (const char*)g.A + (size_t)nxt.pm * tstep : cA; const char* nB = has_next ? (const char*)g.Bt + (size_t)nxt.pn * tstep : cB;
        for (int t = 0; t < nt; t += 2) {
            const bool last = (t == nt - 2);
            const char* a1 = cA + (size_t)(t + 1) * kstep;
            const char* a2 = last ? nA : cA + (size_t)(t + 2) * kstep; const char* b2 = last ? nB : cB + (size_t)(t + 2) * kstep;
            const char* a3 = a2 + kstep; const char* b3 = b2 + kstep;
            if (last && has_next) S.a_ready(nxt);
            if constexpr (SP2) {
            PG8_LDB(B0, 0, 0); PG8_LDB(B1, 0, 1); PG8_SCHED; PG8_LDA(At, 0, 0); PG8_STAGE(PG8_SA(1, 1), a1 + hstep, voffA);
            PG8_WAIT_V(8); PG8_WAIT_L(0); PG8_BAR; PG8_MMA(0, 0, At, B0); PG8_MMA(0, 1, At, B1); PG8_BAR; PG8_SCHED;
            PG8_LDA(At, 0, 1); PG8_STAGE(PG8_SB(0, 0), b2, voffB); PG8_STAGE(PG8_SB(0, 1), b2 + hstep, voffB); PG8_STAGE(PG8_SA(0, 0), a2, voffA);
            PG8_WAIT_V(8); PG8_WAIT_L(0); PG8_BAR; PG8_MMA(1, 0, At, B0); PG8_MMA(1, 1, At, B1); PG8_BAR; PG8_SCHED;
            PG8_LDB(B0, 1, 0); PG8_LDB(B1, 1, 1); PG8_SCHED; PG8_LDA(At, 1, 0); PG8_STAGE(PG8_SA(0, 1), a2 + hstep, voffA);
            PG8_WAIT_V(8); PG8_WAIT_L(0); PG8_BAR; PG8_MMA(0, 0, At, B0); PG8_MMA(0, 1, At, B1); PG8_BAR; PG8_SCHED;
            PG8_LDA(At, 1, 1); PG8_STAGE(PG8_SB(1, 0), b3, voffB); PG8_STAGE(PG8_SB(1, 1), b3 + hstep, voffB); PG8_STAGE(PG8_SA(1, 0), a3, voffA);
            PG8_WAIT_V(8); PG8_WAIT_L(0); PG8_BAR; PG8_MMA(1, 0, At, B0); PG8_MMA(1, 1, At, B1); PG8_BAR; PG8_SCHED;
            } else {
            PG8_LDB(B0, 0, 0); PG8_SCHED; PG8_LDA(At, 0, 0); PG8_STAGE(PG8_SA(1, 1), a1 + hstep, voffA);
            PG8_WAIT_L(8); PG8_BAR; PG8_WAIT_L(0); PG8_MMA(0, 0, At, B0); PG8_BAR; PG8_SCHED;
            PG8_LDB(B1, 0, 1); PG8_STAGE(PG8_SB(0, 0), b2, voffB);
            PG8_BAR; PG8_WAIT_L(0); PG8_MMA(0, 1, At, B1); PG8_BAR;
            PG8_LDA(At, 0, 1); PG8_STAGE(PG8_SA(0, 0), a2, voffA);
            PG8_BAR; PG8_WAIT_L(0); PG8_MMA(1, 0, At, B0); PG8_BAR; PG8_SCHED;
            PG8_STAGE(PG8_SB(0, 1), b2 + hstep, voffB);
            PG8_WAIT_V(6); PG8_BAR; PG8_MMA(1, 1, At, B1); PG8_BAR;
            PG8_LDB(B0, 1, 0); PG8_SCHED; PG8_LDA(At, 1, 0); PG8_STAGE(PG8_SA(0, 1), a2 + hstep, voffA);
            PG8_WAIT_L(8); PG8_BAR; PG8_WAIT_L(0); PG8_MMA(0, 0, At, B0); PG8_BAR; PG8_SCHED;
            PG8_LDB(B1, 1, 1); PG8_STAGE(PG8_SB(1, 0), b3, voffB);
            PG8_BAR; PG8_WAIT_L(0); PG8_MMA(0, 1, At, B1); PG8_BAR;
            PG8_LDA(At, 1, 1); PG8_STAGE(PG8_SA(1, 0), a3, voffA);
            PG8_BAR; PG8_WAIT_L(0); PG8_MMA(1, 0, At, B0); PG8_BAR; PG8_SCHED;
            PG8_STAGE(PG8_SB(1, 1), b3 + hstep, voffB);
            PG8_WAIT_V(6); PG8_BAR; PG8_MMA(1, 1, At, B1); PG8_BAR;
            }
        }
        if constexpr (ALIGN_EPI) { if (wr == 0) PG8_BAR; }
        if constexpr (!Epi::AFTER_DRAIN) { E(acc, cur, wr, wc, fr, fq); S.done(cur); __builtin_amdgcn_sched_barrier(0); if (has_next) S.after_epi(nxt); __builtin_amdgcn_sched_barrier(0); }
        if (!has_next) break;
#pragma unroll
        for (int a = 0; a < 2; ++a)
#pragma unroll
            for (int b = 0; b < 2; ++b)
#pragma unroll
                for (int m = 0; m < 4; ++m)
#pragma unroll
                    for (int n = 0; n < 2; ++n) acc[a][b][m][n] = (f32x4){0.f, 0.f, 0.f, 0.f};
        cur = nxt; cA = nA; cB = nB; ++ui;
        if constexpr (ALIGN_EPI) { if (wr == 1) PG8_BAR; }
    }
    PG8_WAIT_V(0);
    if constexpr (!ALIGN_EPI) { if (wr == 0) PG8_BAR; }
    PG8_BAR;
    if constexpr (Epi::AFTER_DRAIN) { E.fused(acc, cur, wr, wc, fr, fq, lds, wid, lane); S.done(cur); }
#undef PG8_SA
#undef PG8_SB
#undef PG8_STAGE
#undef PG8_LDA
#undef PG8_LDB
#undef PG8_MMA
#undef PG8_WAIT_V
#undef PG8_WAIT_L
#undef PG8_BAR
#undef PG8_SCHED
}
}

constexpr int NWAVES = 8;
constexpr int D = 4096, NB = 4, SEQ = 4096, M = NB * SEQ, NMETA = 16, LTOK = SEQ + NMETA;
constexpr int GH = 4, DK = 512, DV = 1024, QK = 2048, GV = 4096, GR = 16, GIN = 12304, NQKVR = 12288, MGIN = 12320  ;
constexpr int FF = 11008, NGU = 2 * FF;
constexpr float EPS = 1e-6f;
#define DIAG_POISON 0
#define GS_NO_DMA 0
#define GS_C_PACK 0
#ifndef MK_CUTS
#define MK_CUTS 0u
#endif
constexpr int N_PHASES = 14;

constexpr size_t MiB = 1u << 20;
constexpr size_t WS_CTL = 0, CTL_ZERO_BYTES = 2 * MiB;
constexpr size_t WS_WGIN = 2 * MiB;
constexpr size_t WS_WGOUT = 99 * MiB;
constexpr size_t WS_WGU0 = 131 * MiB;
constexpr size_t WS_WDN0 = 303 * MiB;
constexpr size_t WS_WCIN = 389 * MiB;
constexpr size_t WS_WCOUT = 485 * MiB;
constexpr size_t WS_WGU1 = 517 * MiB;
constexpr size_t WS_WDN1 = 689 * MiB;
constexpr size_t WS_XB = 775 * MiB;
constexpr size_t WS_OG = 903 * MiB;
constexpr size_t WS_PROJ = 1031 * MiB;
constexpr size_t WS_O = 1415 * MiB;
constexpr size_t WS_QDF = 1543 * MiB;
constexpr size_t WS_KDNTF = 1607 * MiB;
constexpr size_t WS_ALOW = 1671 * MiB;
constexpr size_t WS_META = 1672 * MiB;
constexpr size_t WS_SC = 1676 * MiB;
constexpr size_t WS_EBL = 1684 * MiB;
constexpr size_t WS_SSP = 1686 * MiB;
constexpr size_t WS_END = 1690 * MiB;
constexpr size_t MT_XB = 0, MT_PROJ = 128 * 1024, MT_O = MT_PROJ + 800 * 1024, MT_OG = MT_O + 256 * 1024, MT_H = MT_OG + 128 * 1024, MT_ACT = MT_H + 256 * 1024, MT_Z = MT_ACT + 352 * 1024,
                 MT_QDF = 2048 * 1024, MT_KDNTF = MT_QDF + 256 * 1024, MT_SC = MT_KDNTF + 256 * 1024, MT_EBL = MT_SC + 32 * 1024;
static_assert(MT_PROJ + (size_t)16 * MGIN * 4 <= MT_O && MT_Z + 2 * 4096 * 4 <= MT_QDF && MT_EBL + 8 * 1024 <= 4 * MiB, "meta map");
constexpr int CW_BAR = 4096;
constexpr int CW_SS = 262144;
constexpr int CW_MSS = CW_SS + 5 * M;
constexpr int MSS_STRIDE = 64;
static_assert((size_t)(CW_MSS + 5 * MSS_STRIDE) * 4 <= CTL_ZERO_BYTES && CW_BAR + N_PHASES * 3456 <= CW_SS, "ctl map");

constexpr int RING_OFF = 0, RING_BYTES = 131072;
constexpr int LDS_BYTES = 163840, LDSCTL_OFF = LDS_BYTES - 1024, MISC_OFF = LDSCTL_OFF + 320;

#define GAS __attribute__((address_space(1)))
#define LAS __attribute__((address_space(3)))
typedef unsigned short bf16;
typedef unsigned v4u __attribute__((ext_vector_type(4)));
typedef unsigned v2u __attribute__((ext_vector_type(2)));
typedef float f32x4 __attribute__((ext_vector_type(4)));
typedef short bf16x8 __attribute__((ext_vector_type(8)));
#define LDS_WAIT() asm volatile("s_waitcnt lgkmcnt(0)" ::: "memory")
#define VM_WAIT() asm volatile("s_waitcnt vmcnt(0)" ::: "memory")
__device__ __forceinline__ unsigned f2bf(float f) { unsigned u = __builtin_bit_cast(unsigned, f); return (u + 0x7fffu + ((u >> 16) & 1u)) >> 16; }
__device__ __forceinline__ unsigned pk2(float lo, float hi) { return f2bf(lo) | (f2bf(hi) << 16); }
__device__ __forceinline__ float bf2f(unsigned short b) { return __builtin_bit_cast(float, (unsigned)b << 16); }
__device__ __forceinline__ float bflo(unsigned w) { return __builtin_bit_cast(float, w << 16); }
__device__ __forceinline__ float bfhi(unsigned w) { return __builtin_bit_cast(float, w & 0xffff0000u); }
__device__ __forceinline__ float wave_sum(float v) {
#pragma unroll
    for (int o = 1; o < 64; o <<= 1) v += __shfl_xor(v, o);
    return v;
}
using pg8::rstd_of; using pg8::silu_f;

#define XB_TMO      128
#define XB_XCNT(j)  (256  + 64 * (j))
#define XB_XSUB(j)  (1280 + 64 * (j))
#define XB_XGEN(j)  (2304 + 64 * (j))
#define XB_TOP      3328
#define XB_TOPGEN   3392
#define XCD_BAR_WORDS 3456
#define XB_SPIN_CAP (1u << 18)

__device__ __forceinline__ unsigned xb_ld(unsigned* p)              { return __hip_atomic_load(p, __ATOMIC_RELAXED, __HIP_MEMORY_SCOPE_AGENT); }
__device__ __forceinline__ unsigned xb_add(unsigned* p, unsigned v) { return __hip_atomic_fetch_add(p, v, __ATOMIC_RELAXED, __HIP_MEMORY_SCOPE_AGENT); }
__device__ __forceinline__ unsigned xb_xcc_id() { return (unsigned)__builtin_amdgcn_s_getreg((3 << 11) | 20) & 0xFu; }
#define XB_SPIN(cond, bar) do { unsigned _sp = 0; while (cond) { __builtin_amdgcn_s_sleep(1); \
    if ((++_sp & 255u) == 0u) { if (xb_ld(&(bar)[XB_TMO])) break; if (_sp > XB_SPIN_CAP) { atomicAdd(&(bar)[XB_TMO], 1u); break; } } } } while (0)

struct XcdBarrier {
    unsigned* bar; unsigned x;
    volatile LAS unsigned* st;
};

__device__ __forceinline__ XcdBarrier xcd_barrier_post(unsigned* bar, volatile LAS unsigned* st) {
    XcdBarrier b; b.bar = bar; b.x = xb_xcc_id(); b.st = st;
    if (threadIdx.x == 0) (void)xb_add(&bar[XB_XCNT(b.x)], 1u);
    return b;
}
__device__ __forceinline__ void xcd_barrier_complete(unsigned* bar, unsigned x, unsigned& nloc, unsigned& nx) {
    const unsigned G = gridDim.x * gridDim.y * gridDim.z;
    unsigned sum, cnt, mine, sp = 0u;
    for (;;) {
        sum = 0u; cnt = 0u; mine = 0u;
#pragma unroll
        for (unsigned j = 0; j < 16; ++j) { const unsigned c = xb_ld(&bar[XB_XCNT(j)]); sum += c; cnt += (c > 0u) ? 1u : 0u; mine = (j == x) ? c : mine; }
        if (sum == G) break;
        __builtin_amdgcn_s_sleep(1);
        if ((++sp & 255u) == 0u) { if (xb_ld(&bar[XB_TMO])) break; if (sp > XB_SPIN_CAP) { atomicAdd(&bar[XB_TMO], 1u); break; } }
    }
    nloc = mine > 0u ? mine : 1u; nx = cnt > 0u ? cnt : 1u;
}

__device__ __forceinline__ void xcd_barrier(const XcdBarrier& b) {
    asm volatile("s_waitcnt vmcnt(0)" ::: "memory");
    __syncthreads();
    if (threadIdx.x == 0) {
        unsigned* bar = b.bar;
        __builtin_amdgcn_s_waitcnt(0);
        unsigned nloc = b.st[0], nx = b.st[1];
        if (nloc == 0u) { xcd_barrier_complete(bar, b.x, nloc, nx); b.st[0] = nloc; b.st[1] = nx; }
        const unsigned old = xb_add(&bar[XB_XSUB(b.x)], 1u);
        const unsigned gen = old / nloc;
        if (old + 1u == (gen + 1u) * nloc) {
            __builtin_amdgcn_fence(__ATOMIC_RELEASE, "agent");
            asm volatile("s_waitcnt vmcnt(0)" ::: "memory");
            const unsigned og = xb_add(&bar[XB_TOP], 1u);
            const unsigned tg = og / nx;
            if (og + 1u == (tg + 1u) * nx) xb_add(&bar[XB_TOPGEN], 1u);
            else XB_SPIN(xb_ld(&bar[XB_TOPGEN]) == tg, bar);
            __builtin_amdgcn_fence(__ATOMIC_ACQUIRE, "agent");
            xb_add(&bar[XB_XGEN(b.x)], 1u);
            asm volatile("s_waitcnt vmcnt(0)" ::: "memory");
        } else {
            XB_SPIN(xb_ld(&bar[XB_XGEN(b.x)]) == gen, bar);
            __builtin_amdgcn_fence(__ATOMIC_ACQUIRE, "agent");
            asm volatile("s_waitcnt vmcnt(0)" ::: "memory");
        }
    }
    __syncthreads();
}

template <int MODE>
__device__ __forceinline__ void cvt_task(const float* __restrict__ W, int K, int ldw, int ncols, const float* __restrict__ gk, bf16* __restrict__ WT, LAS float* scr, int gw, int ngw, int lane) {
    const int nblk = (ncols + 31) / 32, nitems = (K / 64) * nblk, n = lane & 31, hi = lane >> 5, c = lane & 7;
    float v[32];
#define CVT_LOAD(it_) do { const int kb_ = (it_) / nblk, n0_ = ((it_) % nblk) * 32; const bool ok_ = n0_ + n < ncols; const float* wp_ = W + (size_t)(kb_ * 64 + hi) * ldw + n0_ + n; \
        _Pragma("unroll") for (int i = 0; i < 32; ++i) v[i] = ok_ ? wp_[(size_t)(2 * i) * ldw] : 0.f; } while (0)
    int it = gw;
    if (it < nitems) CVT_LOAD(it);
    while (it < nitems) {
        const int kb = it / nblk, n0 = (it % nblk) * 32, k0 = kb * 64; const int ncv = (ncols - n0) < 32 ? (ncols - n0) : 32;
        long dr = n0; if (MODE == 1) dr = (long)(n0 / 128) * 256 + (n0 % 128); if (MODE == 2) dr = (long)(n0 / 128) * 256 + 128 + (n0 % 128);
#pragma unroll
        for (int i = 0; i < 32; ++i) scr[(2 * i + hi) * 33 + n] = v[i];
        f32x4 ga = {1.f, 1.f, 1.f, 1.f}, gb = {1.f, 1.f, 1.f, 1.f};
        if (gk) { ga = *(const f32x4*)(gk + k0 + 8 * c); gb = *(const f32x4*)(gk + k0 + 8 * c + 4); }
        const int nxt = it + ngw;
        if (nxt < nitems) CVT_LOAD(nxt);
        LDS_WAIT(); asm volatile("" ::: "memory");
#pragma unroll
        for (int j = 0; j < 4; ++j) { const int nn = (lane >> 3) + 8 * j; const LAS float* s = scr + (8 * c) * 33 + nn;
            v4u o; o.x = pk2(s[0 * 33] * ga.x, s[1 * 33] * ga.y); o.y = pk2(s[2 * 33] * ga.z, s[3 * 33] * ga.w); o.z = pk2(s[4 * 33] * gb.x, s[5 * 33] * gb.y); o.w = pk2(s[6 * 33] * gb.z, s[7 * 33] * gb.w);
            if (nn < ncv) *(v4u*)(WT + (size_t)(dr + nn) * K + k0 + 8 * c) = o; }
        LDS_WAIT(); asm volatile("" ::: "memory");
        it = nxt;
    }
#undef CVT_LOAD
}
__device__ __forceinline__ void row_to_bf16_ss(const float* xrow, bf16* orow, float* ss, int lane) {
    const f32x4* xr = (const f32x4*)xrow + lane; f32x4 v[16]; float s = 0.f;
#pragma unroll
    for (int j = 0; j < 16; ++j) { v[j] = xr[64 * j]; s += (v[j].x * v[j].x + v[j].y * v[j].y) + (v[j].z * v[j].z + v[j].w * v[j].w); }
    s = wave_sum(s); if (lane == 0) *ss = s;
    v2u* o8 = (v2u*)orow + lane;
#pragma unroll
    for (int j = 0; j < 16; ++j) { v2u w; w.x = pk2(v[j].x, v[j].y); w.y = pk2(v[j].z, v[j].w); o8[64 * j] = w; }
}

template <bool PAIR, class Epi>
__device__ __forceinline__ void thin_gemm16(LAS unsigned char* lds, const bf16* __restrict__ A16, const bf16* __restrict__ Bt, int K, int ntiles, long pair_off, const Epi& epi, int wg, int nwg) {
    const int tid = threadIdx.x, wave = __builtin_amdgcn_readfirstlane(tid >> 6), lane = tid & 63, i = lane & 15, q = lane >> 4;
    LAS float* red = (LAS float*)lds;
    const int nblk = K / 128, kb0 = wave * nblk / 8, kb1 = (wave + 1) * nblk / 8;
    for (int t4 = wg * 4; t4 < ntiles; t4 += nwg * 4)
    for (int t = t4; t < t4 + 4 && t < ntiles; ++t) {
        const long n0 = epi.row0(t);
        const bf16* ap = A16 + (size_t)i * K + 32 * q;
        const bf16* bp = Bt + (size_t)(n0 + i) * K + 32 * q;
        const bf16* bp2 = bp + (size_t)pair_off * K;
        f32x4 acc0 = {0.f, 0.f, 0.f, 0.f}, acc1 = {0.f, 0.f, 0.f, 0.f};
#pragma unroll 2
        for (int kb = kb0; kb < kb1; ++kb) {
            const bf16x8* a = (const bf16x8*)(ap + kb * 128); const bf16x8* b = (const bf16x8*)(bp + kb * 128);
            const bf16x8 a0 = a[0], a1 = a[1], a2 = a[2], a3 = a[3], b0 = b[0], b1 = b[1], b2 = b[2], b3 = b[3];
            acc0 = __builtin_amdgcn_mfma_f32_16x16x32_bf16(a0, b0, acc0, 0, 0, 0); acc0 = __builtin_amdgcn_mfma_f32_16x16x32_bf16(a1, b1, acc0, 0, 0, 0);
            acc0 = __builtin_amdgcn_mfma_f32_16x16x32_bf16(a2, b2, acc0, 0, 0, 0); acc0 = __builtin_amdgcn_mfma_f32_16x16x32_bf16(a3, b3, acc0, 0, 0, 0);
            if (PAIR) { const bf16x8* c = (const bf16x8*)(bp2 + kb * 128); const bf16x8 c0 = c[0], c1 = c[1], c2 = c[2], c3 = c[3];
                acc1 = __builtin_amdgcn_mfma_f32_16x16x32_bf16(a0, c0, acc1, 0, 0, 0); acc1 = __builtin_amdgcn_mfma_f32_16x16x32_bf16(a1, c1, acc1, 0, 0, 0);
                acc1 = __builtin_amdgcn_mfma_f32_16x16x32_bf16(a2, c2, acc1, 0, 0, 0); acc1 = __builtin_amdgcn_mfma_f32_16x16x32_bf16(a3, c3, acc1, 0, 0, 0); }
        }
#pragma unroll
        for (int j = 0; j < 4; ++j) { red[((wave * 2 + 0) * 4 + j) * 64 + lane] = acc0[j]; if (PAIR) red[((wave * 2 + 1) * 4 + j) * 64 + lane] = acc1[j]; }
        __syncthreads();
        if (tid < 256) { const int l = tid & 63, j = tid >> 6; float v0 = 0.f, v1 = 0.f;
#pragma unroll
            for (int w = 0; w < 8; ++w) { v0 += red[((w * 2 + 0) * 4 + j) * 64 + l]; if (PAIR) v1 += red[((w * 2 + 1) * 4 + j) * 64 + l]; }
            epi(t, 4 * (l >> 4) + j, l & 15, v0, v1); }
        __syncthreads();
    }
}


__device__ __forceinline__ void thin_row_rstd(LAS float* tbl, const float* __restrict__ X) {
    const int tid = threadIdx.x, r = tid >> 5, l = tid & 31; const f32x4* xr = (const f32x4*)(X + (size_t)r * D) + l; float s = 0.f;
#pragma unroll 8
    for (int j = 0; j < 32; ++j) { const f32x4 v = xr[32 * j]; s += (v.x * v.x + v.y * v.y) + (v.z * v.z + v.w * v.w); }
    s += __shfl_xor(s, 1); s += __shfl_xor(s, 2); s += __shfl_xor(s, 4); s += __shfl_xor(s, 8); s += __shfl_xor(s, 16);
    if (l == 0) tbl[r] = rstd_of(s);
    __syncthreads();
}

struct TE_ALow {
    float* alow; const float* ss;
    __device__ __forceinline__ long row0(int t) const { return (long)t * 16; }
    __device__ __forceinline__ void operator()(int t, int r, int c, float v0, float) const { const int tok = t * 16 + c; alow[(size_t)tok * 16 + r] = v0 * rstd_of(ss[tok]); }
};
struct TE_MProj {
    float* mproj; const LAS float* rs;
    __device__ __forceinline__ long row0(int t) const { return (long)t * 16; }
    __device__ __forceinline__ void operator()(int t, int r, int c, float v0, float) const { mproj[(size_t)r * MGIN + t * 16 + c] = v0 * rs[r]; }
};
struct TE_MResid {
    const float* resid; float* mh; bf16* mxb; float* mss_out;
    __device__ __forceinline__ long row0(int t) const { return (long)t * 16; }
    __device__ __forceinline__ void operator()(int t, int r, int c, float v0, float) const {
        const size_t o = (size_t)r * D + t * 16 + c; const float h = resid[o] + v0; mh[o] = h; mxb[o] = (bf16)f2bf(h);
        (void)mss_out;
    }
};
struct TE_MSwiGLU {
    bf16* mact; const LAS float* rs;
    __device__ __forceinline__ long row0(int t) const { return (long)(t >> 3) * 256 + (t & 7) * 16; }
    __device__ __forceinline__ void operator()(int t, int r, int c, float v0, float v1) const { const float sc = rs[r];
        mact[(size_t)r * FF + (t >> 3) * 128 + (t & 7) * 16 + c] = (bf16)f2bf(silu_f(v0 * sc) * (v1 * sc)); }
};
struct TE_MConvZ {
    float* zm; const LAS float* rs;
    __device__ __forceinline__ long row0(int t) const { return 4096 + (long)(t >> 3) * 256 + (t & 7) * 16; }
    __device__ __forceinline__ void operator()(int t, int r, int c, float v0, float v1) const { const float sc = rs[r];
        if (r >= 14) zm[(size_t)(r - 14) * D + t * 16 + c] = (v0 * sc) * (v1 * sc); }
};

typedef float f32x16 __attribute__((ext_vector_type(16)));
#define MFMA32(a, b, c) __builtin_amdgcn_mfma_f32_32x32x16_bf16((a), (b), (c), 0, 0, 0)
constexpr int GP_LD = 1040;
constexpr int GP_QD = 0, GP_KDN = 64 * GP_LD, GP_AL = 2 * 64 * GP_LD;
constexpr int GS_KT = 0, GS_OP = 65536, GS_VT = 131072, GS_VT_LD = 144, GS_EB = GS_VT + 64 * GS_VT_LD;
constexpr int GLA_ITEM_FR = 64 * 512;
__device__ __forceinline__ bf16x8 pack_step(const f32x16& x, int s) {
    v4u p;
#if GS_C_PACK
    if (s == 0) { p[0] = pk2(x[0], x[1]); p[1] = pk2(x[2], x[3]); p[2] = pk2(x[4], x[5]); p[3] = pk2(x[6], x[7]); }
    else { p[0] = pk2(x[8], x[9]); p[1] = pk2(x[10], x[11]); p[2] = pk2(x[12], x[13]); p[3] = pk2(x[14], x[15]); }
    return __builtin_bit_cast(bf16x8, p);
#endif
    if (s == 0) asm volatile("v_cvt_pk_bf16_f32 %0, %4, %5\n\tv_cvt_pk_bf16_f32 %1, %6, %7\n\tv_cvt_pk_bf16_f32 %2, %8, %9\n\tv_cvt_pk_bf16_f32 %3, %10, %11\n\ts_nop 1"
               : "=&v"(p[0]), "=&v"(p[1]), "=&v"(p[2]), "=&v"(p[3]) : "v"(x[0]), "v"(x[1]), "v"(x[2]), "v"(x[3]), "v"(x[4]), "v"(x[5]), "v"(x[6]), "v"(x[7]));
    else asm volatile("v_cvt_pk_bf16_f32 %0, %4, %5\n\tv_cvt_pk_bf16_f32 %1, %6, %7\n\tv_cvt_pk_bf16_f32 %2, %8, %9\n\tv_cvt_pk_bf16_f32 %3, %10, %11\n\ts_nop 1"
               : "=&v"(p[0]), "=&v"(p[1]), "=&v"(p[2]), "=&v"(p[3]) : "v"(x[8]), "v"(x[9]), "v"(x[10]), "v"(x[11]), "v"(x[12]), "v"(x[13]), "v"(x[14]), "v"(x[15]));
    return __builtin_bit_cast(bf16x8, p);
}
__device__ __forceinline__ void gla_prep_item(LAS unsigned char* sm, bool meta, const bf16* __restrict__ prow  , const float* __restrict__ arow  ,
                                              const float* __restrict__ MPROJ, int h, const float* __restrict__ w_a2, const float* __restrict__ b_a,
                                              bf16* __restrict__ qdf, bf16* __restrict__ kdntf, bf16* __restrict__ sc, float* __restrict__ ebl) {
    const int tid = threadIdx.x, wave = __builtin_amdgcn_readfirstlane(tid >> 6), lane = tid & 63, k = tid, kcol = h * DK + k;
    LAS float* AL = (LAS float*)(sm + GP_AL);
    if (tid < 256) { f32x4 a4 = {0.f, 0.f, 0.f, 0.f};
        if (!meta) a4 = *((const f32x4*)arow + tid);
        else { const int t = tid >> 2; if (t >= 48) a4 = *((const f32x4*)(MPROJ + (size_t)(t - 48) * MGIN + NQKVR) + (tid & 3)); }
        *((LAS f32x4*)AL + tid) = a4; }
    float w[16];
#pragma unroll
    for (int r = 0; r < 16; ++r) w[r] = w_a2[r * QK + kcol];
    const float ba = b_a[kcol];
    __syncthreads();
    float bc = 0.f;
    for (int g8 = 0; g8 < 8; ++g8) {
        float qv[8], kv[8];
#pragma unroll
        for (int e = 0; e < 8; ++e) { const int t = g8 * 8 + e;
            if (!meta) { qv[e] = bf2f(prow[(size_t)t * NQKVR + kcol]); kv[e] = bf2f(prow[(size_t)t * NQKVR + QK + kcol]); }
            else if (t >= 48) { qv[e] = MPROJ[(size_t)(t - 48) * MGIN + kcol]; kv[e] = MPROJ[(size_t)(t - 48) * MGIN + QK + kcol]; }
            else { qv[e] = 0.f; kv[e] = 0.f; } }
        unsigned kp[4];
#pragma unroll
        for (int e = 0; e < 8; ++e) { const int t = g8 * 8 + e;
            if (!meta || t >= 48) {
                float x = ba;
#pragma unroll
                for (int r4 = 0; r4 < 4; ++r4) { const f32x4 a4 = *((const LAS f32x4*)AL + t * 4 + r4); x += a4.x * w[4 * r4] + a4.y * w[4 * r4 + 1] + a4.z * w[4 * r4 + 2] + a4.w * w[4 * r4 + 3]; }
                const float ls = fminf(x, 0.f) - __logf(1.0f + __expf(-fabsf(x)));
                bc += ls * (1.0f / 16.0f); }
            const float eb = __expf(bc), en = 1.0f / eb;
            const unsigned qd = f2bf(qv[e] * eb * 0.04419417382415922f), kd = f2bf(kv[e] * en);
            *(LAS unsigned short*)(sm + GP_QD + t * GP_LD + k * 2) = (unsigned short)qd;
            *(LAS unsigned short*)(sm + GP_KDN + t * GP_LD + k * 2) = (unsigned short)kd;
            if (e & 1) kp[e >> 1] |= kd << 16; else kp[e >> 1] = kd; }
        { v4u o; o.x = kp[0]; o.y = kp[1]; o.z = kp[2]; o.w = kp[3];
          *(v4u*)(kdntf + ((size_t)(((k >> 5) * 4 + (g8 >> 1)) * 64 + (k & 31) + 32 * (g8 & 1))) * 8) = o; }
    }
    ebl[k] = __expf(bc);
    __syncthreads();
    const int r = lane & 31, hh = lane >> 5;
    if (wave < 4) {
        const int ti = wave & 1, tj = wave >> 1;
        f32x16 acc;
#pragma unroll
        for (int i = 0; i < 16; ++i) acc[i] = 0.f;
        const LAS unsigned char* pa = sm + GP_QD + (32 * ti + r) * GP_LD + 16 * hh; const LAS unsigned char* pb = sm + GP_KDN + (32 * tj + r) * GP_LD + 16 * hh;
#pragma unroll 8
        for (int kb = 0; kb < 32; ++kb) { const bf16x8 a = *(const LAS bf16x8*)(pa + kb * 32), b = *(const LAS bf16x8*)(pb + kb * 32); acc = MFMA32(a, b, acc); }
#pragma unroll
        for (int i = 0; i < 16; ++i) { const int ii = 32 * ti + (i & 3) + 8 * (i >> 2) + 4 * hh, jj = 32 * tj + r; sc[ii * 64 + jj] = (bf16)f2bf(jj <= ii ? acc[i] : 0.f); }
    } else {
        const int t2 = tid - 256;
#pragma unroll 4
        for (int n = 0; n < 16; ++n) { const int pi = t2 + 256 * n, f = pi >> 6, l = pi & 63, rr = l & 31, h2 = l >> 5, kt = f >> 2, s = (f >> 1) & 1, tt = f & 1;
            const LAS unsigned char* src = sm + GP_QD + (32 * tt + rr) * GP_LD + (32 * kt + 16 * s + 4 * h2) * 2;
            const v2u lo = *(const LAS v2u*)src, hi = *(const LAS v2u*)(src + 16);
            v4u o; o.x = lo.x; o.y = lo.y; o.z = hi.x; o.w = hi.y;
            *(v4u*)(qdf + (size_t)pi * 8) = o; }
    }
    __syncthreads();
}
__device__ __forceinline__ void gla_scan(LAS unsigned char* sm, const bf16* __restrict__ PROJ, const float* __restrict__ MPROJ, const bf16* __restrict__ QDF, const bf16* __restrict__ KDNTF, const bf16* __restrict__ SC,
                                         const float* __restrict__ EBL, const bf16* __restrict__ MQDF, const bf16* __restrict__ MKDNTF, const bf16* __restrict__ MSC, const float* __restrict__ MEBL,
                                         bf16* __restrict__ O, float* __restrict__ MO) {
    const int tid = threadIdx.x, wave = __builtin_amdgcn_readfirstlane(tid >> 6), lane = tid & 63, r = lane & 31, hh = lane >> 5, half = wave >> 2, js = wave & 3;
    const int sa_off = (r * 64 + 16 * js + 8 * hh) * 2;
    const int vt_ = lane, v8_ = wave * 8;
    const LAS unsigned char* vb0 = sm + GS_VT + (32 * half + r) * GS_VT_LD + 16 * hh;
    const LAS unsigned char* vb1 = sm + GS_VT + (32 * (half ^ 1) + r) * GS_VT_LD + 16 * hh;
    const LAS unsigned char* eb_rd = sm + GS_EB + (64 * wave + 4 * hh) * 4;
    LAS unsigned char* op_wr = sm + wave * 16384 + lane * 4;
    const int op_y0 = half * 4096, op_y1 = (half ^ 1) * 4096;
    const LAS unsigned char* op_rd = sm + (tid >> 4) * 256 + (tid & 15) * 16;
    const int red_t = 8 * ((tid >> 6) & 3) + 4 * ((tid >> 3) & 1) + ((tid >> 4) & 3), red_v = 32 * ((tid >> 8) & 1) + 4 * (tid & 7);
    for (int u0 = blockIdx.x; u0 < 256; u0 += gridDim.x) {
        const int u = gridDim.x == 256 ? ((u0 & 7) * 2 + (u0 >> 7)) * 16 + ((u0 >> 3) & 15) : u0;
        const int b = u >> 6, h = (u >> 4) & 3, vs = u & 15;
        f32x16 S00, S01, S10, S11;
#pragma unroll
        for (int i = 0; i < 16; ++i) { S00[i] = 0.f; S01[i] = 0.f; S10[i] = 0.f; S11[i] = 0.f; }
        bf16x8 qa[8], ka[8], sa[2]; v4u vreg; f32x4 ereg = {0.f, 0.f, 0.f, 0.f};
        const char* const mqf = (const char*)(MQDF + (size_t)h * GLA_ITEM_FR); const char* const mkf = (const char*)(MKDNTF + (size_t)h * GLA_ITEM_FR);
        const char* const msc = (const char*)(MSC + (size_t)h * 4096); const float* const meb = MEBL + h * DK;
#define GS_ITEM(c) const size_t it_ = ((size_t)b * 64 + (size_t)((c) > 0 ? (c) - 1 : 0)) * GH + h; \
            const char* qf_ = (c) == 0 ? mqf : (const char*)(QDF + it_ * GLA_ITEM_FR); const char* kf_ = (c) == 0 ? mkf : (const char*)(KDNTF + it_ * GLA_ITEM_FR); \
            const char* sc_ = (c) == 0 ? msc : (const char*)(SC + it_ * 4096); const float* eb_ = (c) == 0 ? meb : EBL + it_ * DK; (void)qf_; (void)kf_; (void)sc_; (void)eb_
#define GS_OPQ(name, val) int name##_i = (val); asm volatile("" : "+v"(name##_i)); const size_t name = (size_t)(unsigned)name##_i
#define GS_LOAD_Q(c) do { GS_ITEM(c); const char* qb_ = qf_ + wave * 8192; GS_OPQ(l16_, lane * 16); GS_OPQ(sao_, (int)sa_off); \
            _Pragma("unroll") for (int f = 0; f < 8; ++f) qa[f] = *(const bf16x8*)(qb_ + f * 1024 + l16_); \
            sa[0] = *(const bf16x8*)(sc_ + sao_); sa[1] = *(const bf16x8*)(sc_ + 4096 + sao_); } while (0)
#define GS_LOAD_K(c) do { GS_ITEM(c); const char* kb_ = kf_ + wave * 8192; GS_OPQ(l16_, lane * 16); \
            _Pragma("unroll") for (int j = 0; j < 8; ++j) ka[j] = *(const bf16x8*)(kb_ + j * 1024 + l16_); } while (0)
#define GS_LOAD_V(c) do { GS_ITEM(c); \
            if (tid < 128) { GS_OPQ(eo_, tid * 16); ereg = *(const f32x4*)((const char*)eb_ + eo_); } \
            if ((c) == 0) { if (vt_ >= 48) { GS_OPQ(vo_, ((vt_ - 48) * MGIN + v8_) * 4); const float* vp = (const float*)((const char*)(MPROJ + 2 * QK + h * DV + vs * 64) + vo_); const f32x4 x0 = *(const f32x4*)vp, x1 = *(const f32x4*)(vp + 4); \
                                  vreg.x = pk2(x0.x, x0.y); vreg.y = pk2(x0.z, x0.w); vreg.z = pk2(x1.x, x1.y); vreg.w = pk2(x1.z, x1.w); } else { vreg = (v4u){0u, 0u, 0u, 0u}; } } \
            else { GS_OPQ(vo_, (vt_ * NQKVR + v8_) * 2); vreg = *(const v4u*)((const char*)(PROJ + ((size_t)b * SEQ + (size_t)(((c) - 1) * 64)) * NQKVR + 2 * QK + h * DV + vs * 64) + vo_); } } while (0)
#define GS_STEP1() do { _Pragma("unroll") for (int e = 0; e < 8; ++e) { const unsigned wv = vreg[e >> 1]; *(LAS unsigned short*)(sm + GS_VT + (v8_ + e) * GS_VT_LD + vt_ * 2) = (unsigned short)((e & 1) ? (wv >> 16) : (wv & 0xffffu)); } \
            if (tid < 128) *((LAS f32x4*)(sm + GS_EB) + tid) = ereg; } while (0)
        GS_LOAD_V(0); GS_LOAD_Q(0);
        GS_STEP1();
#pragma unroll 1
        for (int c = 0; c <= 64; ++c) {
            __syncthreads();
            GS_LOAD_K(c);
            if (c < 64) GS_LOAD_V(c + 1);
            __builtin_amdgcn_sched_barrier(0);
#define GS_OHALF(Sa, Sb, vbp, sfrag, tsel, opy) do { f32x16 o0, o1; _Pragma("unroll") for (int i = 0; i < 16; ++i) { o0[i] = 0.f; o1[i] = 0.f; } \
              _Pragma("unroll") for (int s = 0; s < 2; ++s) { const bf16x8 sb = pack_step(Sa, s); o0 = MFMA32(qa[s * 2 + 0], sb, o0); o1 = MFMA32(qa[s * 2 + 1], sb, o1); } \
              _Pragma("unroll") for (int s = 0; s < 2; ++s) { const bf16x8 sb = pack_step(Sb, s); o0 = MFMA32(qa[4 + s * 2 + 0], sb, o0); o1 = MFMA32(qa[4 + s * 2 + 1], sb, o1); } \
              { const bf16x8 vI = *(const LAS bf16x8*)((vbp) + js * 32); if (tsel == 0) o0 = MFMA32(sfrag, vI, o0); else o1 = MFMA32(sfrag, vI, o1); } \
              _Pragma("unroll") for (int i = 0; i < 16; ++i) { *(LAS float*)(op_wr + (opy) + i * 256) = o0[i]; *(LAS float*)(op_wr + 8192 + (opy) + i * 256) = o1[i]; } \
              __builtin_amdgcn_sched_barrier(0); } while (0)
            GS_OHALF(S00, S10, vb0, sa[0], 0, op_y0);
            GS_OHALF(S01, S11, vb1, sa[1], 1, op_y1);
            {
              bf16x8 vB0[4], vB1[4];
#pragma unroll
              for (int ts = 0; ts < 4; ++ts) { vB0[ts] = *(const LAS bf16x8*)(vb0 + ts * 32); vB1[ts] = *(const LAS bf16x8*)(vb1 + ts * 32); }
              f32x4 ea[4], ec[4];
#define GS_EBLD(e, kt) do { _Pragma("unroll") for (int g4 = 0; g4 < 4; ++g4) e[g4] = *(const LAS f32x4*)(eb_rd + (32 * (kt) + 8 * g4) * 4); } while (0)
#define GS_EBMUL(Sx, e) do { _Pragma("unroll") for (int g4 = 0; g4 < 4; ++g4) { Sx[4 * g4 + 0] *= e[g4].x; Sx[4 * g4 + 1] *= e[g4].y; Sx[4 * g4 + 2] *= e[g4].z; Sx[4 * g4 + 3] *= e[g4].w; } \
                asm volatile("" : "+v"(Sx));     } while (0)
              GS_EBLD(ea, 0); GS_EBLD(ec, 1);
#pragma unroll
              for (int ts = 0; ts < 4; ++ts) {
                S00 = MFMA32(ka[ts], vB0[ts], S00); S01 = MFMA32(ka[ts], vB1[ts], S01); S10 = MFMA32(ka[4 + ts], vB0[ts], S10); S11 = MFMA32(ka[4 + ts], vB1[ts], S11); }
              __builtin_amdgcn_sched_barrier(0);
              if (c < 64) GS_LOAD_Q(c + 1);
              __builtin_amdgcn_sched_barrier(0);
              GS_EBMUL(S00, ea); GS_EBMUL(S01, ea); __builtin_amdgcn_sched_barrier(0);
              GS_EBMUL(S10, ec); GS_EBMUL(S11, ec); __builtin_amdgcn_sched_barrier(0);
#undef GS_EBLD
#undef GS_EBMUL
            }
            __syncthreads();
            if (c < 64) GS_STEP1();
            { int lo = (red_t * GV + red_v) * 2; asm volatile("" : "+v"(lo));
              const char* const ob = (const char*)(O + ((size_t)b * SEQ + (size_t)((c > 0 ? c - 1 : 0) * 64)) * GV + h * DV + vs * 64);
#pragma unroll
              for (int p = 0; p < 2; ++p) {
                f32x4 s4 = *(const LAS f32x4*)(op_rd + p * 8192);
#pragma unroll
                for (int w8 = 1; w8 < 8; ++w8) { const f32x4 x = *(const LAS f32x4*)(op_rd + w8 * 16384 + p * 8192); s4.x += x.x; s4.y += x.y; s4.z += x.z; s4.w += x.w; }
                if (p == 1 && c == 0 && b == 0 && red_t >= 16) *(f32x4*)(MO + (size_t)(red_t - 16) * GV + h * DV + vs * 64 + red_v) = s4;
                { v2u w; w.x = pk2(s4.x, s4.y); w.y = pk2(s4.z, s4.w); *(v2u*)(ob + (size_t)p * (32 * GV * 2) + lo) = w; } } }
            __builtin_amdgcn_sched_barrier(0);
        }
#undef GS_ITEM
#undef GS_LOAD_Q
#undef GS_LOAD_K
#undef GS_LOAD_V
#undef GS_OPQ
#undef GS_OHALF
#undef GS_STEP1
        __syncthreads();
    }
}

template <bool OBF>
__device__ __forceinline__ void gate_item(const void* orow  , const float* __restrict__ hn, f32x4 (&rv)[4], bf16* og, int lane) {
    f32x4 v[4]; float s = 0.f;
#pragma unroll
    for (int j = 0; j < 4; ++j) {
        if (OBF) { const v2u w = *((const v2u*)orow + lane + 64 * j); v[j] = (f32x4){bflo(w.x), bfhi(w.x), bflo(w.y), bfhi(w.y)}; }
        else v[j] = *((const f32x4*)orow + lane + 64 * j);
        s += (v[j].x * v[j].x + v[j].y * v[j].y) + (v[j].z * v[j].z + v[j].w * v[j].w); }
    const float rs = 1.0f / sqrtf(wave_sum(s) * (1.0f / DV) + EPS);
#pragma unroll
    for (int j = 0; j < 4; ++j) { const f32x4 g = *((const f32x4*)hn + lane + 64 * j);
        v2u w; w.x = pk2(v[j].x * rs * g.x * silu_f(rv[j].x), v[j].y * rs * g.y * silu_f(rv[j].y)); w.y = pk2(v[j].z * rs * g.z * silu_f(rv[j].z), v[j].w * rs * g.w * silu_f(rv[j].w));
        *((v2u*)og + lane + 64 * j) = w; }
}

struct Args { const float* in[16]; float* out; unsigned char* ws; int ph_lo, ph_hi, li, pad; };
enum { I_X = 0, I_META, I_NMIX, I_NFFN, I_GWIN, I_GWA2, I_GBA, I_GHN, I_GWOUT, I_CWIN, I_CW, I_CWOUT, I_FGATE, I_FUP, I_FDOWN, I_NFINAL };

__global__ void __launch_bounds__(NWAVES * 64, 2) trunk_fwd(Args args) {
    extern __shared__ __attribute__((aligned(16))) unsigned char lds_raw[];
    LAS unsigned char* lds = (LAS unsigned char*)lds_raw;
    volatile LAS unsigned* MISC = (volatile LAS unsigned*)(lds + MISC_OFF);
    const int tid = threadIdx.x, lane = tid & 63, wave = __builtin_amdgcn_readfirstlane(tid >> 6);
    const int G = gridDim.x, bx = blockIdx.x;
    const int gw = bx * NWAVES + wave, NGW = G * NWAVES;
    unsigned char* ws = args.ws;
    unsigned* ctl = (unsigned*)(ws + WS_CTL);
    float* SS = (float*)ctl + CW_SS; float* MSS = (float*)ctl + CW_MSS; float* SSP = (float*)(ws + WS_SSP); constexpr size_t SSP_N = (size_t)64 * 16 * 256 * 4;
    const float* x = args.in[I_X]; float* out = args.out;
    bf16* W_GIN = (bf16*)(ws + WS_WGIN); bf16* W_GOUT = (bf16*)(ws + WS_WGOUT); bf16* W_GU0 = (bf16*)(ws + WS_WGU0); bf16* W_DN0 = (bf16*)(ws + WS_WDN0);
    bf16* W_CIN = (bf16*)(ws + WS_WCIN); bf16* W_COUT = (bf16*)(ws + WS_WCOUT); bf16* W_GU1 = (bf16*)(ws + WS_WGU1); bf16* W_DN1 = (bf16*)(ws + WS_WDN1);
    bf16* XB = (bf16*)(ws + WS_XB); bf16* OG = (bf16*)(ws + WS_OG); bf16* PROJ = (bf16*)(ws + WS_PROJ); bf16* ACT = PROJ; bf16* CBG = PROJ; bf16* CZ = PROJ + (size_t)M * D;
    bf16* O = (bf16*)(ws + WS_O); float* ALOW = (float*)(ws + WS_ALOW);
    bf16* QDF = (bf16*)(ws + WS_QDF); bf16* KDNTF = (bf16*)(ws + WS_KDNTF); bf16* SC = (bf16*)(ws + WS_SC); float* EBL = (float*)(ws + WS_EBL);
    unsigned char* mt = ws + WS_META;
    bf16* MXB = (bf16*)(mt + MT_XB); float* MPROJ = (float*)(mt + MT_PROJ); float* MO = (float*)(mt + MT_O); bf16* MOG = (bf16*)(mt + MT_OG); float* MH = (float*)(mt + MT_H);
    bf16* MACT = (bf16*)(mt + MT_ACT); float* ZM = (float*)(mt + MT_Z);
    bf16* MQDF = (bf16*)(mt + MT_QDF); bf16* MKDNTF = (bf16*)(mt + MT_KDNTF); bf16* MSC = (bf16*)(mt + MT_SC); float* MEBL = (float*)(mt + MT_EBL);

    for (int u = tid; u < 1024 / 4; u += NWAVES * 64) ((LAS unsigned*)(lds + LDSCTL_OFF))[u] = 0u;
    __syncthreads();
    const int lo = args.ph_lo, hi = args.ph_hi;
    XcdBarrier bar; bar.bar = ctl + CW_BAR + args.li * XCD_BAR_WORDS; bar.x = 0; bar.st = nullptr;
    if (hi - lo > 1) bar = xcd_barrier_post(ctl + CW_BAR + args.li * XCD_BAR_WORDS, MISC + 8);
#ifndef ONLY_PHASE
#define ONLY_PHASE -1
#endif
#define IN(k) (lo <= (k) && (k) < hi && (ONLY_PHASE < 0 || (k) == ONLY_PHASE))
#define SEAM(k) do { if (IN(k) && IN((k) + 1)) xcd_barrier(bar); } while (0)

    if (IN(0)) {
        LAS float* scr = (LAS float*)(lds + RING_OFF + wave * 16384);
        cvt_task<0>(args.in[I_GWIN], D, GIN, GIN, args.in[I_NMIX], W_GIN, scr, gw, NGW, lane);
        cvt_task<0>(args.in[I_GWOUT], GV, D, D, nullptr, W_GOUT, scr, gw, NGW, lane);
        cvt_task<1>(args.in[I_FGATE], D, FF, FF, args.in[I_NFFN], W_GU0, scr, gw, NGW, lane);
        cvt_task<2>(args.in[I_FUP], D, FF, FF, args.in[I_NFFN], W_GU0, scr, gw, NGW, lane);
        cvt_task<0>(args.in[I_FDOWN], FF, D, D, nullptr, W_DN0, scr, gw, NGW, lane);
        cvt_task<0>(args.in[I_CWIN], D, NQKVR, D, args.in[I_NMIX] + D, W_CIN, scr, gw, NGW, lane);
        cvt_task<1>(args.in[I_CWIN] + D, D, NQKVR, D, args.in[I_NMIX] + D, W_CIN + (size_t)D * D, scr, gw, NGW, lane);
        cvt_task<2>(args.in[I_CWIN] + 2 * D, D, NQKVR, D, args.in[I_NMIX] + D, W_CIN + (size_t)D * D, scr, gw, NGW, lane);
        cvt_task<0>(args.in[I_CWOUT], D, D, D, nullptr, W_COUT, scr, gw, NGW, lane);
        cvt_task<1>(args.in[I_FGATE] + (size_t)D * FF, D, FF, FF, args.in[I_NFFN] + D, W_GU1, scr, gw, NGW, lane);
        cvt_task<2>(args.in[I_FUP] + (size_t)D * FF, D, FF, FF, args.in[I_NFFN] + D, W_GU1, scr, gw, NGW, lane);
        cvt_task<0>(args.in[I_FDOWN] + (size_t)FF * D, FF, D, D, nullptr, W_DN1, scr, gw, NGW, lane);
        for (int blk = bx; blk < M / 64; blk += G)
            for (int i = 0; i < 8; ++i) { const int m = blk * 64 + wave * 8 + i; row_to_bf16_ss(x + (size_t)m * D, XB + (size_t)m * D, SS + m, lane); }
        if (bx == 0) for (int i = 0; i < 2; ++i) { const int m = wave * 2 + i; row_to_bf16_ss(args.in[I_META] + (size_t)m * D, MXB + (size_t)m * D, MSS + m, lane); }
        for (int oc = bx; oc < NMETA * GR; oc += G) {
            const int r = oc >> 4, c = oc & 15; const float* mr = args.in[I_META] + (size_t)r * D; const float* gm = args.in[I_NMIX]; const float* wi = args.in[I_GWIN] + NQKVR + c;
            float ssq = 0.f, acc = 0.f;
#pragma unroll
            for (int j = 0; j < 8; ++j) { const int k = tid + 512 * j; const float xv = mr[k]; ssq += xv * xv; acc += xv * gm[k] * wi[(size_t)k * GIN]; }
            ssq = wave_sum(ssq); acc = wave_sum(acc);
            LAS float* rd = (LAS float*)(lds + RING_OFF + 8 * 16384);
            __syncthreads(); if (lane == 0) { rd[wave] = ssq; rd[8 + wave] = acc; } __syncthreads();
            if (tid == 0) { float s2 = 0.f, a2 = 0.f; for (int w = 0; w < 8; ++w) { s2 += rd[w]; a2 += rd[8 + w]; } MPROJ[(size_t)r * MGIN + NQKVR + c] = a2 * rstd_of(s2); } }
    }
    SEAM(0);

    if (IN(1)) {
        { TE_ALow e{ALOW, SS}; thin_gemm16<false>(lds + RING_OFF, W_GIN + (size_t)NQKVR * D, XB, D, M / 16, 0, e, bx, G); }
        { LAS float* rt = (LAS float*)(lds + RING_OFF + 16384); thin_row_rstd(rt, args.in[I_META]); TE_MProj e{MPROJ, rt}; thin_gemm16<false>(lds + RING_OFF, MXB, W_GIN, D, NQKVR / 16, 0, e, bx, G); }
        pg8::Gemm g{XB, W_GIN, M, NQKVR, D}; pg8::RstdOrder S; S.init(M, NQKVR, G, bx); S.ssp = nullptr; S.ss0 = SS; S.npn = 0; S.cnt = 0;
        pg8::EpiScaleBf16 E{PROJ, NQKVR, 0};
        pg8::gemm_phase<pg8::EpiScaleBf16, pg8::RstdOrder, true, true>(lds + RING_OFF, g, S, E);
    }
    SEAM(1);

    if (IN(2)) {
        LAS unsigned char* sm = lds + RING_OFF;
        if (bx < GH) gla_prep_item(sm, true, PROJ, ALOW, MPROJ, bx, args.in[I_GWA2], args.in[I_GBA], MQDF + (size_t)bx * GLA_ITEM_FR, MKDNTF + (size_t)bx * GLA_ITEM_FR, MSC + (size_t)bx * 4096, MEBL + bx * DK);
        for (int it = bx; it < NB * 64 * GH; it += G) { const int h = it & 3; const size_t m0 = (size_t)(it >> 2) * 64;
            gla_prep_item(sm, false, PROJ + m0 * NQKVR, ALOW + m0 * 16, MPROJ, h, args.in[I_GWA2], args.in[I_GBA], QDF + (size_t)it * GLA_ITEM_FR, KDNTF + (size_t)it * GLA_ITEM_FR, SC + (size_t)it * 4096, EBL + (size_t)it * DK); }
    }
    SEAM(2);

#ifndef NO_SCAN
    if (IN(3)) gla_scan(lds + RING_OFF, PROJ, MPROJ, QDF, KDNTF, SC, EBL, MQDF, MKDNTF, MSC, MEBL, O, MO);
#endif
    SEAM(3);

    if (IN(4)) {
        const float* hn = args.in[I_GHN];
        for (int it = gw; it < M * GH; it += NGW) { const int m = it >> 2, h = it & 3; f32x4 rv[4];
            const v2u* rp = (const v2u*)(PROJ + (size_t)m * NQKVR + 2 * QK + GV + h * DV);
#pragma unroll
            for (int j = 0; j < 4; ++j) { const v2u w = rp[lane + 64 * j]; rv[j] = (f32x4){bflo(w.x), bfhi(w.x), bflo(w.y), bfhi(w.y)}; }
            gate_item<true>(O + (size_t)m * GV + h * DV, hn, rv, OG + (size_t)m * GV + h * DV, lane); }
        if (gw < NMETA * GH) { const int m = gw >> 2, h = gw & 3; f32x4 rv[4];
#pragma unroll
            for (int j = 0; j < 4; ++j) rv[j] = *((const f32x4*)(MPROJ + (size_t)m * MGIN + 2 * QK + GV + h * DV) + lane + 64 * j);
            gate_item<false>(MO + (size_t)m * GV + h * DV, hn, rv, MOG + (size_t)m * GV + h * DV, lane); }
    }
    SEAM(4);

    if (IN(5)) {
        { TE_MResid e{args.in[I_META], MH, MXB, MSS + MSS_STRIDE}; thin_gemm16<false>(lds + RING_OFF, MOG, W_GOUT, GV, D / 16, 0, e, bx, G); }
        pg8::Gemm g{OG, W_GOUT, M, D, GV}; pg8::StaticOrder S; S.init(M, D, G, bx);
        pg8::EpiResid<false> E{x, XB, SSP, D};
        pg8::gemm_phase<pg8::EpiResid<false>, pg8::StaticOrder, true, true>(lds + RING_OFF, g, S, E);
    }
    SEAM(5);

    if (IN(6)) {
        const bool thin_in_tail = G == 256;
        if (!thin_in_tail) { LAS float* rt = (LAS float*)(lds + RING_OFF + 16384); thin_row_rstd(rt, MH); TE_MSwiGLU e{MACT, rt}; thin_gemm16<true>(lds + RING_OFF, MXB, W_GU0, D, FF / 16, 128, e, bx, G); }
        pg8::Gemm g{XB, W_GU0, M, NGU, D}; pg8::RstdOrder S; S.init(M, NGU, G, bx); S.ssp = SSP; S.ss0 = nullptr; S.npn = D / 256; S.cnt = 0;
        pg8::EpiSwiGLU E{ACT, FF, 0};
        pg8::gemm_phase<pg8::EpiSwiGLU, pg8::RstdOrder, true, true>(lds + RING_OFF, g, S, E);
        if (thin_in_tail && bx >= 128) { __syncthreads();
            LAS float* rt = (LAS float*)(lds + RING_OFF + 16384); thin_row_rstd(rt, MH); TE_MSwiGLU e{MACT, rt}; thin_gemm16<true>(lds + RING_OFF, MXB, W_GU0, D, FF / 16, 128, e, bx - 128, 128); }
    }
    SEAM(6);

    if (IN(7)) {
        { TE_MResid e{MH, MH, MXB, MSS + 2 * MSS_STRIDE}; thin_gemm16<false>(lds + RING_OFF, MACT, W_DN0, FF, D / 16, 0, e, bx, G); }
        pg8::Gemm g{ACT, W_DN0, M, D, FF}; pg8::StaticOrderPN S; S.init(M, D, G, bx);
        pg8::EpiResid<true> E{nullptr, XB, SSP + SSP_N, D};
        pg8::gemm_phase<pg8::EpiResid<true>, pg8::StaticOrderPN, true, true>(lds + RING_OFF, g, S, E);
    }
    SEAM(7);

    if (IN(8)) {
        { LAS float* rt = (LAS float*)(lds + RING_OFF + 16384); thin_row_rstd(rt, MH); TE_MConvZ e{ZM, rt}; thin_gemm16<true>(lds + RING_OFF, MXB, W_CIN, D, D / 16, 128, e, bx, G); }
        { pg8::Gemm g{XB, W_CIN, M, D, D}; pg8::RstdOrder S; S.init(M, D, G, bx); S.ssp = SSP + SSP_N; S.ss0 = nullptr; S.npn = D / 256; S.cnt = 0;
          pg8::EpiScaleBf16 E{CBG, D, 0};
          pg8::gemm_phase<pg8::EpiScaleBf16, pg8::RstdOrder, true, true>(lds + RING_OFF, g, S, E); }
        __syncthreads();
        { pg8::Gemm g{XB, W_CIN + (size_t)D * D, M, 2 * D, D}; pg8::RstdOrder S; S.init(M, 2 * D, G, bx); S.ssp = SSP + SSP_N; S.ss0 = nullptr; S.npn = D / 256; S.cnt = 0;
          pg8::EpiMul E{CZ, D, 0};
          pg8::gemm_phase<pg8::EpiMul, pg8::RstdOrder, true, true>(lds + RING_OFF, g, S, E); }
    }
    SEAM(8);

    if (IN(9)) {
        const float* cw = args.in[I_CW];
        const int c0 = tid * 8;
        float w0[8], w1[8], w2[8];
#pragma unroll
        for (int j = 0; j < 8; ++j) { w0[j] = cw[c0 + j]; w1[j] = cw[D + c0 + j]; w2[j] = cw[2 * D + c0 + j]; }
        for (int run = bx; run < M / 64; run += G) {
            const int m0 = run * 64, s0 = m0 & (SEQ - 1);
            float z1[8], z2[8];
            if (s0 == 0) {
#pragma unroll
                for (int j = 0; j < 8; ++j) { z2[j] = ZM[c0 + j]; z1[j] = ZM[D + c0 + j]; }
            } else {
                const v4u zq2 = *(const v4u*)(CZ + (size_t)(m0 - 2) * D + c0), zq1 = *(const v4u*)(CZ + (size_t)(m0 - 1) * D + c0);
#pragma unroll
                for (int j = 0; j < 4; ++j) { z2[2 * j] = bflo(zq2[j]); z2[2 * j + 1] = bfhi(zq2[j]); z1[2 * j] = bflo(zq1[j]); z1[2 * j + 1] = bfhi(zq1[j]); }
            }
#pragma unroll 4
            for (int rr = 0; rr < 64; ++rr) {
                const v4u bg = *(const v4u*)(CBG + (size_t)(m0 + rr) * D + c0), zq = *(const v4u*)(CZ + (size_t)(m0 + rr) * D + c0);
                float z[8], y[8];
#pragma unroll
                for (int j = 0; j < 4; ++j) { z[2 * j] = bflo(zq[j]); z[2 * j + 1] = bfhi(zq[j]); }
#pragma unroll
                for (int j = 0; j < 8; ++j) { const float cv = w2[j] * z[j] + w1[j] * z1[j] + w0[j] * z2[j]; const float bgf = (j & 1) ? bfhi(bg[j >> 1]) : bflo(bg[j >> 1]); y[j] = bgf * cv; z2[j] = z1[j]; z1[j] = z[j]; }
                v4u o; o.x = pk2(y[0], y[1]); o.y = pk2(y[2], y[3]); o.z = pk2(y[4], y[5]); o.w = pk2(y[6], y[7]);
                *(v4u*)(OG + (size_t)(m0 + rr) * D + c0) = o;
            }
        }
    }
    SEAM(9);

    if (IN(10)) {
        pg8::Gemm g{OG, W_COUT, M, D, D}; pg8::StaticOrder S; S.init(M, D, G, bx);
        pg8::EpiResid<true> E{nullptr, XB, SSP + 2 * SSP_N, D};
        pg8::gemm_phase<pg8::EpiResid<true>, pg8::StaticOrder, true, true>(lds + RING_OFF, g, S, E);
    }
    SEAM(10);

    if (IN(11)) {
        pg8::Gemm g{XB, W_GU1, M, NGU, D}; pg8::RstdOrder S; S.init(M, NGU, G, bx); S.ssp = SSP + 2 * SSP_N; S.ss0 = nullptr; S.npn = D / 256; S.cnt = 0;
        pg8::EpiSwiGLU E{ACT, FF, 0};
        pg8::gemm_phase<pg8::EpiSwiGLU, pg8::RstdOrder, true, true>(lds + RING_OFF, g, S, E);
    }
    SEAM(11);

    if (IN(12)) {
        pg8::Gemm g{ACT, W_DN1, M, D, FF}; pg8::StaticOrderPN S; S.init(M, D, G, bx);
        pg8::EpiResid<true> E{nullptr, XB, SSP, D};
        pg8::gemm_phase<pg8::EpiResid<true>, pg8::StaticOrderPN, true, true>(lds + RING_OFF, g, S, E);
    }
    SEAM(12);

    if (IN(13)) {
        const float* gf = args.in[I_NFINAL];
        bool bad = false;
        for (int r = 0; r < N_PHASES; ++r) bad |= __hip_atomic_load(ctl + CW_BAR + r * XCD_BAR_WORDS + XB_TMO, __ATOMIC_RELAXED, __HIP_MEMORY_SCOPE_AGENT) != 0u;
        for (int m = gw; m < M; m += NGW) { const v4u* xr = (const v4u*)(XB + (size_t)m * D) + lane; f32x4* row = (f32x4*)(out + (size_t)m * D) + 2 * lane; v4u q[8]; float ssq = 0.f;
#pragma unroll
            for (int j = 0; j < 8; ++j) { q[j] = xr[64 * j];
#pragma unroll
                for (int e = 0; e < 4; ++e) { const float lo = bflo(q[j][e]), hi = bfhi(q[j][e]); ssq += lo * lo + hi * hi; } }
            const float rs = bad ? __builtin_nanf("") : rstd_of(wave_sum(ssq));
#pragma unroll
            for (int j = 0; j < 8; ++j) { const f32x4 g0 = *((const f32x4*)gf + 2 * lane + 128 * j), g1 = *((const f32x4*)gf + 2 * lane + 128 * j + 1);
                f32x4 o0, o1; o0.x = bflo(q[j].x) * rs * g0.x; o0.y = bfhi(q[j].x) * rs * g0.y; o0.z = bflo(q[j].y) * rs * g0.z; o0.w = bfhi(q[j].y) * rs * g0.w;
                o1.x = bflo(q[j].z) * rs * g1.x; o1.y = bfhi(q[j].z) * rs * g1.y; o1.z = bflo(q[j].w) * rs * g1.z; o1.w = bfhi(q[j].w) * rs * g1.w;
                row[128 * j] = o0; row[128 * j + 1] = o1; } }
    }
#undef IN
#undef SEAM
}

extern "C" void kernel_launch(void* const* d_in, const int* in_sizes, int n_in, void* d_out, int out_size, void* d_ws, size_t ws_size, hipStream_t stream) {
    static int grid = 0;
    if (grid == 0) {
        if (n_in != 16 || in_sizes[0] != M * D || out_size != M * D || ws_size < WS_END) { fprintf(stderr, "kernel_launch: unexpected problem (n_in %d, in0 %d, out %d, ws %zu < %zu)\n", n_in, n_in > 0 ? in_sizes[0] : -1, out_size, ws_size, (size_t)WS_END); grid = -1; return; }
        int dev = 0, cus = 0, per_cu = 0;
        if (hipGetDevice(&dev) != hipSuccess || hipDeviceGetAttribute(&cus, hipDeviceAttributeMultiprocessorCount, dev) != hipSuccess) { grid = -1; return; }
        if (hipFuncSetAttribute((const void*)trunk_fwd, hipFuncAttributeMaxDynamicSharedMemorySize, LDS_BYTES) != hipSuccess) { fprintf(stderr, "kernel_launch: hipFuncSetAttribute failed\n"); grid = -1; return; }
        if (hipOccupancyMaxActiveBlocksPerMultiprocessor(&per_cu, (const void*)trunk_fwd, NWAVES * 64, LDS_BYTES) != hipSuccess || per_cu < 1)
            fprintf(stderr, "kernel_launch: note: occupancy query reports %d workgroups per CU\n", per_cu);
        (void)hipGetLastError();
        grid = cus;
    }
    if (grid < 0) return;
#if DIAG_POISON
    (void)hipMemsetAsync((char*)d_ws + CTL_ZERO_BYTES, 0xAA, WS_END - CTL_ZERO_BYTES, stream);
    (void)hipMemsetAsync(d_out, 0xAA, (size_t)M * D * 4, stream);
#endif
    if (hipMemsetAsync((char*)d_ws + WS_CTL, 0, CTL_ZERO_BYTES, stream) != hipSuccess) { fprintf(stderr, "kernel_launch: memset failed\n"); return; }
    Args a{};
    for (int i = 0; i < 16; ++i) a.in[i] = (const float*)d_in[i];
    a.out = (float*)d_out; a.ws = (unsigned char*)d_ws;
    int li = 0;
    for (int p0 = 0; p0 < N_PHASES; ++li) {
        int p1 = p0 + 1; while (p1 < N_PHASES && !((MK_CUTS >> (p1 - 1)) & 1u)) ++p1;
        a.ph_lo = p0; a.ph_hi = p1; a.li = li; p0 = p1;
        hipLaunchKernelGGL(trunk_fwd, dim3(grid), dim3(NWAVES * 64), LDS_BYTES, stream, a);
        const hipError_t le = hipPeekAtLastError();
        if (le != hipSuccess) { fprintf(stderr, "kernel_launch: launch %d failed: %s\n", li, hipGetErrorName(le)); break; }
    }
}
```
